# Optimizing an MI355X kernel written in HIP

```python
import jax
import jax.numpy as jnp
from jax import lax
import numpy as np

D_MODEL = 2048
BATCH = 2
SEQ = 4096
DEPTH = 1
DEC_BATCH = 16
DEC_SEQ = 16
PAST_LEN = 1024

CHUNK = 64
Q_BLOCK = 128
SB_HEADS = 8
SB_HEAD_DIM = 128
SB_WIDTH = SB_HEADS * SB_HEAD_DIM
MLA_HEADS = 8
Q_LORA = 512
KV_LORA = 512
NOPE_DIM = 128
ROPE_DIM = 64
V_DIM = 128
MLA_WIDTH = MLA_HEADS * V_DIM
ROPE_THETA = 10000.0
D_FF = 5504
LN_EPS = 1e-5
RMS_EPS = 1e-6
ALPHA = (2 * DEPTH) ** 0.25
DN_BETA = (8 * DEPTH) ** -0.25
SB_SCALE = SB_HEAD_DIM ** -0.5
MLA_SCALE = (NOPE_DIM + ROPE_DIM) ** -0.5
IN_SPLITS = (SB_WIDTH, 2 * SB_WIDTH, 3 * SB_WIDTH, 3 * SB_WIDTH + Q_LORA,
             3 * SB_WIDTH + Q_LORA + KV_LORA, 3 * SB_WIDTH + Q_LORA + KV_LORA + ROPE_DIM)
IN_COLS = IN_SPLITS[-1] + 2 * D_MODEL

kernel_name = 'stickbreak_mla_macaron_deepnorm_stream_step'


def layer_norm(x, g, b):
    xf = x.astype(jnp.float32)
    mu = jnp.mean(xf, -1, keepdims=True)
    var = jnp.mean(jnp.square(xf - mu), -1, keepdims=True)
    y = (xf - mu) * lax.rsqrt(var + LN_EPS) * g.astype(jnp.float32) + b.astype(jnp.float32)
    return y.astype(x.dtype)


def rms_norm(x, g):
    xf = x.astype(jnp.float32)
    y = xf * lax.rsqrt(jnp.mean(jnp.square(xf), -1, keepdims=True) + RMS_EPS) * g.astype(jnp.float32)
    return y.astype(x.dtype)


def rope(x, pos):
    half = ROPE_DIM // 2
    inv_freq = ROPE_THETA ** (-jnp.arange(0, ROPE_DIM, 2, dtype=jnp.float32) / ROPE_DIM)
    ang = pos.astype(jnp.float32)[:, None] * inv_freq[None, :]
    ang = ang.reshape(ang.shape[0], *([1] * (x.ndim - 3)), half)
    cos, sin = jnp.cos(ang), jnp.sin(ang)
    xf = x.astype(jnp.float32)
    x1, x2 = xf[..., :half], xf[..., half:]
    return jnp.concatenate([x1 * cos - x2 * sin, x2 * cos + x1 * sin], -1).astype(x.dtype)


def swiglu(x, w_in, w_out):
    gate, up = jnp.split(x @ w_in, 2, axis=-1)
    return (jax.nn.silu(gate) * up) @ w_out


def stick_breaking(q, k, v, q_pos, k_pos):
    z = jnp.einsum('bqhd,bkhd->bhqk', q.astype(jnp.float32), k.astype(jnp.float32)) * SB_SCALE
    visible = k_pos[None, :] < q_pos[:, None]
    log_1m = jnp.where(visible, jax.nn.log_sigmoid(-z), 0.0)
    tail = lax.cumsum(log_1m, axis=3, reverse=True) - log_1m
    a = jnp.where(visible, jnp.exp(jax.nn.log_sigmoid(z) + tail), 0.0)
    return jnp.einsum('bhqk,bkhd->bqhd', a, v.astype(jnp.float32))


def mla_attend(q_nope, q_rope, k_nope, k_rope, v, q_pos, k_pos):
    s = (jnp.einsum('bqhd,bkhd->bhqk', q_nope.astype(jnp.float32), k_nope.astype(jnp.float32))
         + jnp.einsum('bqhr,bkr->bhqk', q_rope.astype(jnp.float32), k_rope.astype(jnp.float32))) * MLA_SCALE
    visible = (k_pos[None, :] // CHUNK) <= (q_pos[:, None] // CHUNK)
    s = jnp.where(visible, s, jnp.finfo(jnp.float32).min)
    p = jax.nn.softmax(s, axis=-1)
    return jnp.einsum('bhqk,bkhd->bqhd', p, v.astype(jnp.float32))


def map_query_blocks(attend, q_parts, q_pos):
    n_blocks = q_pos.shape[0] // Q_BLOCK

    def to_blocks(a):
        a = a.reshape(a.shape[0], n_blocks, Q_BLOCK, *a.shape[2:])
        return jnp.moveaxis(a, 1, 0)

    xs = tuple(to_blocks(a) for a in q_parts) + (q_pos.reshape(n_blocks, Q_BLOCK),)
    out = lax.map(lambda blk: attend(*blk), xs)
    out = jnp.moveaxis(out, 0, 1)
    return out.reshape(out.shape[0], n_blocks * Q_BLOCK, *out.shape[3:])


def token_mixing(h, pos, past, past_pos, p, blocked):
    past_k, past_v, past_ckv, past_kr = past
    B, T, _ = h.shape
    u = h @ p['w_in']
    q_sb, k_sb, v_sb, c_q, c_kv, k_r, gates = jnp.split(u, IN_SPLITS, axis=-1)
    q_sb = q_sb.reshape(B, T, SB_HEADS, SB_HEAD_DIM)
    k_sb = k_sb.reshape(B, T, SB_HEADS, SB_HEAD_DIM)
    v_sb = v_sb.reshape(B, T, SB_HEADS, SB_HEAD_DIM)
    q_mla = (rms_norm(c_q, p['g_cq']) @ p['w_uq']).reshape(B, T, MLA_HEADS, NOPE_DIM + ROPE_DIM)
    q_nope, q_rope = q_mla[..., :NOPE_DIM], rope(q_mla[..., NOPE_DIM:], pos)
    c_kv = rms_norm(c_kv, p['g_ckv'])
    k_r = rope(k_r, pos)
    k_pos = jnp.concatenate([past_pos, pos])
    k_all = jnp.concatenate([past_k, k_sb], axis=1)
    v_all = jnp.concatenate([past_v, v_sb], axis=1)
    ckv_all = jnp.concatenate([past_ckv, c_kv], axis=1)
    kr_all = jnp.concatenate([past_kr, k_r], axis=1)
    kv = (ckv_all @ p['w_ukv']).reshape(B, k_pos.shape[0], MLA_HEADS, NOPE_DIM + V_DIM)
    k_nope, v_mla = kv[..., :NOPE_DIM], kv[..., NOPE_DIM:]

    sb_fn = lambda q, qp: stick_breaking(q, k_all, v_all, qp, k_pos)
    mla_fn = lambda qn, qr, qp: mla_attend(qn, qr, k_nope, kr_all, v_mla, qp, k_pos)
    if blocked:
        o_sb = map_query_blocks(sb_fn, (q_sb,), pos)
        o_mla = map_query_blocks(mla_fn, (q_nope, q_rope), pos)
    else:
        o_sb = sb_fn(q_sb, pos)
        o_mla = mla_fn(q_nope, q_rope, pos)
    o_sb = o_sb.reshape(B, T, SB_WIDTH).astype(h.dtype)
    o_mla = o_mla.reshape(B, T, MLA_WIDTH).astype(h.dtype)
    g = jax.nn.sigmoid((gates + p['b_gate']).astype(jnp.float32))
    g_sb, g_mla = g[..., :D_MODEL], g[..., D_MODEL:]
    merged = g_sb * (o_sb @ p['w_br_sb']).astype(jnp.float32) + g_mla * (o_mla @ p['w_br_mla']).astype(jnp.float32)
    out = merged.astype(h.dtype) @ p['w_o']
    return out, (k_sb, v_sb, c_kv, k_r)


def encoder_layer(x, pos, past, past_pos, p, blocked):
    h = layer_norm(ALPHA * x + 0.5 * swiglu(x, p['ffn1_w_in'], p['ffn1_w_out']), p['ln1_g'], p['ln1_b'])
    mix, new_rows = token_mixing(h, pos, past, past_pos, p, blocked)
    h = layer_norm(ALPHA * h + mix, p['ln2_g'], p['ln2_b'])
    h = layer_norm(ALPHA * h + 0.5 * swiglu(h, p['ffn2_w_in'], p['ffn2_w_out']), p['ln3_g'], p['ln3_b'])
    return h, new_rows


def setup_inputs(seed: int = 0) -> dict:
    key = jax.random.key(seed)
    ks = jax.random.split(key, 32)
    f32 = jnp.float32
    L = DEPTH

    def nrm(k, shape, scale=1.0):
        return jax.random.normal(k, shape, f32) * scale

    return {
        'x_prompt': nrm(ks[0], (BATCH, SEQ, D_MODEL)),
        'x_sample': nrm(ks[1], (DEC_BATCH, DEC_SEQ, D_MODEL)),
        'cache_sb_k': nrm(ks[2], (L, DEC_BATCH, PAST_LEN, SB_HEADS, SB_HEAD_DIM)),
        'cache_sb_v': nrm(ks[3], (L, DEC_BATCH, PAST_LEN, SB_HEADS, SB_HEAD_DIM)),
        'cache_mla_ckv': nrm(ks[4], (L, DEC_BATCH, PAST_LEN, KV_LORA)),
        'cache_mla_krope': nrm(ks[5], (L, DEC_BATCH, PAST_LEN, ROPE_DIM)),
        'ffn1_w_in': nrm(ks[6], (L, D_MODEL, 2 * D_FF), D_MODEL ** -0.5),
        'ffn1_w_out': nrm(ks[7], (L, D_FF, D_MODEL), DN_BETA * D_FF ** -0.5),
        'ln1_g': 1.0 + nrm(ks[8], (L, D_MODEL), 0.02),
        'ln1_b': nrm(ks[9], (L, D_MODEL), 0.02),
        'w_in': nrm(ks[10], (L, D_MODEL, IN_COLS), D_MODEL ** -0.5),
        'b_gate': nrm(ks[11], (L, 2 * D_MODEL), 0.02),
        'g_cq': 1.0 + nrm(ks[12], (L, Q_LORA), 0.02),
        'w_uq': nrm(ks[13], (L, Q_LORA, MLA_HEADS * (NOPE_DIM + ROPE_DIM)), Q_LORA ** -0.5),
        'g_ckv': 1.0 + nrm(ks[14], (L, KV_LORA), 0.02),
        'w_ukv': nrm(ks[15], (L, KV_LORA, MLA_HEADS * (NOPE_DIM + V_DIM)), KV_LORA ** -0.5),
        'w_br_sb': nrm(ks[16], (L, SB_WIDTH, D_MODEL), DN_BETA * SB_WIDTH ** -0.5),
        'w_br_mla': nrm(ks[17], (L, MLA_WIDTH, D_MODEL), DN_BETA * MLA_WIDTH ** -0.5),
        'w_o': nrm(ks[18], (L, D_MODEL, D_MODEL), DN_BETA * D_MODEL ** -0.5),
        'ln2_g': 1.0 + nrm(ks[19], (L, D_MODEL), 0.02),
        'ln2_b': nrm(ks[20], (L, D_MODEL), 0.02),
        'ffn2_w_in': nrm(ks[21], (L, D_MODEL, 2 * D_FF), D_MODEL ** -0.5),
        'ffn2_w_out': nrm(ks[22], (L, D_FF, D_MODEL), DN_BETA * D_FF ** -0.5),
        'ln3_g': 1.0 + nrm(ks[23], (L, D_MODEL), 0.02),
        'ln3_b': nrm(ks[24], (L, D_MODEL), 0.02),
    }


def reference(x_prompt, x_sample, cache_sb_k, cache_sb_v, cache_mla_ckv, cache_mla_krope,
              ffn1_w_in, ffn1_w_out, ln1_g, ln1_b, w_in, b_gate, g_cq, w_uq, g_ckv, w_ukv,
              w_br_sb, w_br_mla, w_o, ln2_g, ln2_b, ffn2_w_in, ffn2_w_out, ln3_g, ln3_b):
    params = dict(ffn1_w_in=ffn1_w_in, ffn1_w_out=ffn1_w_out, ln1_g=ln1_g, ln1_b=ln1_b,
                  w_in=w_in, b_gate=b_gate, g_cq=g_cq, w_uq=w_uq, g_ckv=g_ckv, w_ukv=w_ukv,
                  w_br_sb=w_br_sb, w_br_mla=w_br_mla, w_o=w_o, ln2_g=ln2_g, ln2_b=ln2_b,
                  ffn2_w_in=ffn2_w_in, ffn2_w_out=ffn2_w_out, ln3_g=ln3_g, ln3_b=ln3_b)
    b_p, t_p = x_prompt.shape[0], x_prompt.shape[1]
    t_s = x_sample.shape[1]
    past_len = cache_sb_k.shape[2]
    pos_p = jnp.arange(t_p, dtype=jnp.int32)
    pos_s = past_len + jnp.arange(t_s, dtype=jnp.int32)
    past_pos_p = jnp.arange(0, dtype=jnp.int32)
    past_pos_s = jnp.arange(past_len, dtype=jnp.int32)
    dt = x_prompt.dtype
    no_past = (jnp.zeros((b_p, 0, SB_HEADS, SB_HEAD_DIM), dt), jnp.zeros((b_p, 0, SB_HEADS, SB_HEAD_DIM), dt),
               jnp.zeros((b_p, 0, KV_LORA), dt), jnp.zeros((b_p, 0, ROPE_DIM), dt))

    h_p, h_s = x_prompt, x_sample
    rows_p = ([], [], [], [])
    rows_s = ([], [], [], [])
    for layer in range(DEPTH):
        p = {name: w[layer] for name, w in params.items()}
        h_p, new_p = encoder_layer(h_p, pos_p, no_past, past_pos_p, p, True)
        past_s = (cache_sb_k[layer], cache_sb_v[layer], cache_mla_ckv[layer], cache_mla_krope[layer])
        h_s, new_s = encoder_layer(h_s, pos_s, past_s, past_pos_s, p, False)
        for acc, r in zip(rows_p, new_p):
            acc.append(r)
        for acc, r in zip(rows_s, new_s):
            acc.append(r)

    return (h_p, h_s,
            jnp.stack(rows_p[0]), jnp.stack(rows_p[1]), jnp.stack(rows_p[2]), jnp.stack(rows_p[3]),
            jnp.stack(rows_s[0]), jnp.stack(rows_s[1]), jnp.stack(rows_s[2]), jnp.stack(rows_s[3]))
```

```cpp
#include <hip/hip_runtime.h>
#include <cstdio>
#include <cstdint>
#include <cmath>
constexpr int DM = 2048, NPROMPT = 8192, NSAMPLE = 256, MTOK = NPROMPT + NSAMPLE;
constexpr int SEQ = 4096, DEC_B = 16, DEC_T = 16, PAST = 1024, KEYS_S = PAST + DEC_T;
constexpr int FF = 5504, NIN = 8448;
constexpr int KROWS = NPROMPT + DEC_B * KEYS_S;
constexpr int VPITCH = KROWS + 64;
constexpr float LN_EPS = 1e-5f, RMS_EPS = 1e-6f;
constexpr float ALPHA = 1.18920711500272f;
constexpr float LOG2E = 1.4426950408889634f;
constexpr float SBQ_SCALE = 0.08838834764831845f * LOG2E;
constexpr float MLAQ_SCALE = 0.07216878364870323f * LOG2E;
namespace pg8 {
#define PG8_LAS __attribute__((address_space(3)))
typedef unsigned short bf16_t;
typedef short bf16x8 __attribute__((ext_vector_type(8)));
typedef float f32x4 __attribute__((ext_vector_type(4)));
typedef unsigned u32x4 __attribute__((ext_vector_type(4)));
constexpr int BM = 256, BK = 64, HALF = 128, HTB = HALF * BK * 2  , STAGE_BYTES = 8 * HTB, NXCD = 8, WGM = 8;

__host__ __device__ __forceinline__ int lds_byte(int r, int c) { const int st = (r >> 4) * 2 + (c >> 5), rr = r & 15, cc = c & 31, ob = rr * 64 + cc * 2; return st * 1024 + (ob ^ (((ob >> 9) & 1) << 5)); }
__host__ __device__ __forceinline__ void stage_rc(int b, int& R, int& C) { const int st = b / 1024, sb = b % 1024, swz = sb ^ (((sb >> 9) & 1) << 5); R = (st >> 1) * 16 + swz / 64; C = (st & 1) * 32 + (swz % 64) / 2; }
__host__ __device__ __forceinline__ int perm32(int rho) { const int n = rho >> 4, i = rho & 15; return 8 * (i >> 2) + 4 * n + (i & 3); }

struct Unit { int pm, pn, kofs, nt, chunk, gid; };
struct Gemm { const bf16_t* A; const bf16_t* Bt; int M, N, K; long dA1 = 0, dB1 = 0, dA2 = 0, dB2 = 0; };

struct StaticOrder {
    int nM, nN, nwg, G, c, ntf;
    __host__ __device__ void init(int M, int N, int G_, int c_, int K_) { nM = M / BM; nN = N / BM; nwg = nM * nN; G = G_; c = c_; ntf = K_ / BK; }
    __host__ __device__ bool next(int i, Unit& u) const { const long L = (long)i * G + c; if (L >= nwg) return false; map((int)L, u); return true; }
    __host__ __device__ void map(int L, Unit& u) const {
        int wgid = L; { const int q = nwg / NXCD, r = nwg % NXCD, xcd = wgid % NXCD, off = wgid / NXCD; wgid = (xcd < r ? xcd * (q + 1) : r * (q + 1) + (xcd - r) * q) + off; }
        const int nig = WGM * nN, gid = wgid / nig, fm = gid * WGM, gsz = (nM - fm) < WGM ? (nM - fm) : WGM;
        u.pm = fm + ((wgid % nig) % gsz); u.pn = (wgid % nig) / gsz; u.kofs = 0; u.nt = ntf; u.chunk = -1; u.gid = 0;
    }
    __device__ __forceinline__ void a_ready(const Unit&) const {}
    __device__ __forceinline__ void done(const Unit&) const {}
};

struct SplitOrder {
    StaticOrder P; int nch, base, extra, c;
    __host__ __device__ void init(int N, int G_, int c_, int K_, int coff = 0) { P.init(NPROMPT, N, G_, c_, K_); const int np = K_ / (2 * BK); nch = np < 32 ? np : 32; base = np / nch; extra = np % nch; c = c_ - coff; }
    __host__ __device__ bool next(int i, Unit& u) const {
        if (i == 0) return P.next(0, u);
        if (i > 1 || c < 0 || c >= 8 * nch) return false;
        const int j = c >> 3; u.gid = 0; u.pm = NPROMPT / BM; u.pn = c & 7; u.chunk = j; u.nt = 2 * (base + (j < extra ? 1 : 0)); u.kofs = 2 * BK * (j * base + (j < extra ? j : extra)); return true;
    }
    __device__ __forceinline__ void a_ready(const Unit&) const {}
    __device__ __forceinline__ void done(const Unit&) const {}
};
struct Order3 {
    StaticOrder S0, S1, S2; int G, c;
    __host__ __device__ void init(int M0, int N0, int M1, int N1, int M2, int N2, int G_, int c_, int K_) { S0.init(M0, N0, G_, c_, K_); S1.init(M1, N1, G_, c_, K_); S2.init(M2, N2, G_, c_, K_); G = G_; c = c_; }
    __host__ __device__ bool next(int i, Unit& u) const {
        int L = i * G + c;
        if (L < S0.nwg) { S0.map(L, u); return true; } L -= S0.nwg;
        if (L < S1.nwg) { S1.map(L, u); u.gid = 1; return true; } L -= S1.nwg;
        if (L < S2.nwg) { S2.map(L, u); u.gid = 2; return true; }
        return false;
    }
    __device__ __forceinline__ void a_ready(const Unit&) const {}
    __device__ __forceinline__ void done(const Unit&) const {}
};
struct SplitOrder2 {
    SplitOrder A, B; int nA;
    __host__ __device__ void init(int N, int G_, int c_, int K_) { A.init(N, G_, c_, K_, 0); B.init(N, G_, c_, K_, 64); nA = (A.c >= 0 && A.c < 8 * A.nch) ? 2 : 1; }
    __host__ __device__ bool next(int i, Unit& u) const {
        if (i < nA) { A.next(i, u); u.gid = 0; return true; }
        if (B.next(i - nA, u)) { u.gid = 1; return true; }
        return false;
    }
    __device__ __forceinline__ void a_ready(const Unit&) const {}
    __device__ __forceinline__ void done(const Unit&) const {}
};
constexpr int split_nch(int K_) { return (K_ / 128) < 32 ? (K_ / 128) : 32; }

__device__ __forceinline__ unsigned cvt_pk_bf16(float lo, float hi) { unsigned r; asm volatile("v_cvt_pk_bf16_f32 %0, %1, %2" : "=v"(r) : "v"(lo), "v"(hi)); return r; }
typedef float f32x2 __attribute__((ext_vector_type(2)));
typedef float f32x2_t __attribute__((ext_vector_type(2))); typedef __bf16 bf16x2_t __attribute__((ext_vector_type(2)));
__device__ __forceinline__ unsigned pk2(float lo, float hi) { f32x2_t v = {lo, hi}; bf16x2_t b = __builtin_convertvector(v, bf16x2_t); return __builtin_bit_cast(unsigned, b); }
__device__ __forceinline__ u32x4 pk8(const f32x4 a, const f32x4 b) { u32x4 w; w.x = pk2(a[0], a[1]); w.y = pk2(a[2], a[3]); w.z = pk2(b[0], b[1]); w.w = pk2(b[2], b[3]); return w; }
__device__ __forceinline__ float bf_lo(unsigned w) { return __builtin_bit_cast(float, w << 16); }
__device__ __forceinline__ float bf_hi(unsigned w) { return __builtin_bit_cast(float, w & 0xffff0000u); }
__device__ __forceinline__ void unpk8(const u32x4 w, f32x4& a, f32x4& b) { a = (f32x4){bf_lo(w.x), bf_hi(w.x), bf_lo(w.y), bf_hi(w.y)}; b = (f32x4){bf_lo(w.z), bf_hi(w.z), bf_lo(w.w), bf_hi(w.w)}; }
__device__ __forceinline__ float silu_f(float x) { return x * __builtin_amdgcn_rcpf(1.f + __builtin_amdgcn_exp2f(-1.4426950408889634f * x)); }
__device__ __forceinline__ float sigmoid_f(float x) { return __builtin_amdgcn_rcpf(1.f + __builtin_amdgcn_exp2f(-1.4426950408889634f * x)); }

#define EPI_LOOP_AM _Pragma("unroll") for (int ai = 0; ai < 2; ++ai) _Pragma("unroll") for (int m = 0; m < 4; ++m)

struct EpiSwiGLU {
    static constexpr bool PERM = true, AFTER_DRAIN = false;
    bf16_t* O; int ldc;
    __device__ __forceinline__ void operator()(const f32x4 (&acc)[2][2][4][2], const Unit& u, int wr, int wc, int fr, int fq) const {
        const int row0 = u.pm * BM + wr * 64 + fr, col0 = u.pn * 128 + wc * 32 + 8 * fq;
        EPI_LOOP_AM { bf16_t* p = O + (size_t)(row0 + ai * HALF + m * 16) * ldc + col0;
            f32x4 a, b;
#pragma unroll
            for (int e = 0; e < 4; ++e) { a[e] = silu_f(acc[ai][0][m][0][e]) * acc[ai][1][m][0][e]; b[e] = silu_f(acc[ai][0][m][1][e]) * acc[ai][1][m][1][e]; }
            *(u32x4*)p = pk8(a, b); }
    }
};
struct EpiPlain {
    static constexpr bool PERM = true, AFTER_DRAIN = false;
    bf16_t* O; int ldc;
    __device__ __forceinline__ void operator()(const f32x4 (&acc)[2][2][4][2], const Unit& u, int wr, int wc, int fr, int fq) const {
        const int row0 = u.pm * BM + wr * 64 + fr, col0 = u.pn * BM + wc * 32 + 8 * fq;
        EPI_LOOP_AM { bf16_t* p = O + (size_t)(row0 + ai * HALF + m * 16) * ldc + col0;
#pragma unroll
            for (int bj = 0; bj < 2; ++bj) *(u32x4*)(p + bj * HALF) = pk8(acc[ai][bj][m][0], acc[ai][bj][m][1]); }
    }
};
struct EpiResid {
    static constexpr bool PERM = true, AFTER_DRAIN = false;
    const float* R0; const float* R1; bf16_t* Y; float alpha, s; float* slab;
    __device__ __forceinline__ void operator()(const f32x4 (&acc)[2][2][4][2], const Unit& u, int wr, int wc, int fr, int fq) const {
        const int row0 = u.pm * BM + wr * 64 + fr, col0 = u.pn * BM + wc * 32 + 8 * fq;
        const bool part = u.chunk >= 0;
        const float al = part ? 0.f : alpha, sc = part ? 1.f : s;
        const float* Rb = (u.pm < NPROMPT / BM) ? R0 + (size_t)row0 * DM : R1 + (size_t)(row0 - NPROMPT) * DM;
        float* Sb = slab + ((size_t)(part ? u.chunk : 0) * NSAMPLE + (part ? row0 - NPROMPT : 0)) * DM;
        EPI_LOOP_AM { const size_t ro = (size_t)(ai * HALF + m * 16) * DM + col0; const float* rp = Rb + ro;
#pragma unroll
            for (int bj = 0; bj < 2; ++bj) { const f32x4 r0 = *(const f32x4*)(rp + bj * HALF), r1 = *(const f32x4*)(rp + bj * HALF + 4);
                const f32x4 y0 = r0 * al + acc[ai][bj][m][0] * sc, y1 = r1 * al + acc[ai][bj][m][1] * sc;
                if (part) { *(f32x4*)(Sb + ro + bj * HALF) = y0; *(f32x4*)(Sb + ro + bj * HALF + 4) = y1; }
                else *(u32x4*)(Y + (size_t)row0 * DM + ro + bj * HALF) = pk8(y0, y1); } }
    }
};
struct EpiResidB {
    static constexpr bool PERM = true, AFTER_DRAIN = false;
    const bf16_t* RB; bf16_t* Y; float alpha, s; float* slab;
    __device__ __forceinline__ void operator()(const f32x4 (&acc)[2][2][4][2], const Unit& u, int wr, int wc, int fr, int fq) const {
        const int row0 = u.pm * BM + wr * 64 + fr, col0 = u.pn * BM + wc * 32 + 8 * fq;
        const bool part = u.chunk >= 0;
        const float al = part ? 0.f : alpha, sc = part ? 1.f : s;
        const bf16_t* Rb = RB + (size_t)row0 * DM;
        float* Sb = slab + ((size_t)(part ? u.chunk : 0) * NSAMPLE + (part ? row0 - NPROMPT : 0)) * DM;
        EPI_LOOP_AM { const size_t ro = (size_t)(ai * HALF + m * 16) * DM + col0; const bf16_t* rp = Rb + ro;
#pragma unroll
            for (int bj = 0; bj < 2; ++bj) { f32x4 r0, r1; unpk8(*(const u32x4*)(rp + bj * HALF), r0, r1);
                const f32x4 y0 = r0 * al + acc[ai][bj][m][0] * sc, y1 = r1 * al + acc[ai][bj][m][1] * sc;
                if (part) { *(f32x4*)(Sb + ro + bj * HALF) = y0; *(f32x4*)(Sb + ro + bj * HALF + 4) = y1; }
                else *(u32x4*)(Y + (size_t)row0 * DM + ro + bj * HALF) = pk8(y0, y1); } }
    }
};
struct EpiWin {
    static constexpr bool PERM = true, AFTER_DRAIN = false;
    bf16_t* QS; float* out; float* CQ; float* KR; bf16_t* G; const float* bgate; float qscale;
    __device__ __forceinline__ void operator()(const f32x4 (&acc)[2][2][4][2], const Unit& u, int wr, int wc, int fr, int fq) const {
        const int row0 = u.pm * BM + wr * 64 + fr, colt = wc * 32 + 8 * fq; const int pn = u.pn;
        if (pn < 4) {
            EPI_LOOP_AM { bf16_t* p = QS + (size_t)(row0 + ai * HALF + m * 16) * 1024 + pn * BM + colt;
#pragma unroll
                for (int bj = 0; bj < 2; ++bj) *(u32x4*)(p + bj * HALF) = pk8(acc[ai][bj][m][0] * qscale, acc[ai][bj][m][1] * qscale); }
        } else if (pn < 12) {
            const bool isk = pn < 8; const bool smp = u.pm >= NPROMPT / BM;
            size_t off = isk ? (size_t)17301504 : (size_t)25690112;
            if (smp) off = isk ? (size_t)38797312 : (size_t)39059456;
            const int rr = smp ? row0 - NPROMPT : row0; const int cc = (pn - (isk ? 4 : 8)) * BM + colt;
            EPI_LOOP_AM { float* p = out + off + (size_t)(rr + ai * HALF + m * 16) * 1024 + cc;
#pragma unroll
                for (int bj = 0; bj < 2; ++bj) { *(f32x4*)(p + bj * HALF) = acc[ai][bj][m][0]; *(f32x4*)(p + bj * HALF + 4) = acc[ai][bj][m][1]; } }
        } else if (pn < 16) {
            const size_t off = (pn < 14 ? (size_t)0 : (size_t)MTOK * 512); const int cc = (pn & 1) * BM + colt;
            EPI_LOOP_AM { float* p = CQ + off + (size_t)(row0 + ai * HALF + m * 16) * 512 + cc;
#pragma unroll
                for (int bj = 0; bj < 2; ++bj) { *(f32x4*)(p + bj * HALF) = acc[ai][bj][m][0]; *(f32x4*)(p + bj * HALF + 4) = acc[ai][bj][m][1]; } }
        } else if (pn < 32) {
            const int cc = (pn - 16) * BM + colt;
            f32x4 bg[2][2];
#pragma unroll
            for (int bj = 0; bj < 2; ++bj) { bg[bj][0] = *(const f32x4*)(bgate + cc + bj * HALF); bg[bj][1] = *(const f32x4*)(bgate + cc + bj * HALF + 4); }
            EPI_LOOP_AM { bf16_t* p = G + (size_t)(row0 + ai * HALF + m * 16) * 4096 + cc;
#pragma unroll
                for (int bj = 0; bj < 2; ++bj) { f32x4 a = acc[ai][bj][m][0] + bg[bj][0], b = acc[ai][bj][m][1] + bg[bj][1];
#pragma unroll
                    for (int e = 0; e < 4; ++e) { a[e] = sigmoid_f(a[e]); b[e] = sigmoid_f(b[e]); }
                    *(u32x4*)(p + bj * HALF) = pk8(a, b); } }
        } else {
            if (wc < 2) { EPI_LOOP_AM { float* p = KR + (size_t)(row0 + ai * HALF + m * 16) * 64 + colt; *(f32x4*)p = acc[ai][0][m][0]; *(f32x4*)(p + 4) = acc[ai][0][m][1]; } }
        }
    }
};
struct EpiUq {
    static constexpr bool PERM = true, AFTER_DRAIN = false;
    bf16_t* QM; const float* tab; float scale;
    __device__ __forceinline__ void operator()(const f32x4 (&acc)[2][2][4][2], const Unit& u, int wr, int wc, int fr, int fq) const {
        const int row0 = u.pm * BM + wr * 64 + fr, col0 = u.pn * BM + wc * 32 + 8 * fq;
        EPI_LOOP_AM { const int row = row0 + ai * HALF + m * 16; const int pos = row < NPROMPT ? (row & 4095) : 1024 + ((row - NPROMPT) & 15);
            bf16_t* p = QM + (size_t)row * 1536 + col0;
#pragma unroll
            for (int bj = 0; bj < 2; ++bj) { const int col = col0 + bj * HALF; const int hc = col % 192; f32x4 a = acc[ai][bj][m][0], b = acc[ai][bj][m][1];
                if (hc >= 128) { const float* t = tab + (size_t)pos * 64 + (hc - 128);
                    const f32x4 t0 = *(const f32x4*)t, t1 = *(const f32x4*)(t + 4);
                    const f32x4 a2 = {a[0] * t0[0] - a[1] * t0[1], a[1] * t0[0] + a[0] * t0[1], a[2] * t0[2] - a[3] * t0[3], a[3] * t0[2] + a[2] * t0[3]};
                    const f32x4 b2 = {b[0] * t1[0] - b[1] * t1[1], b[1] * t1[0] + b[0] * t1[1], b[2] * t1[2] - b[3] * t1[3], b[3] * t1[2] + b[2] * t1[3]};
                    a = a2; b = b2; }
                *(u32x4*)(p + bj * HALF) = pk8(a * scale, b * scale); } }
    }
};
struct EpiP6 {
    static constexpr bool PERM = true, AFTER_DRAIN = false;
    EpiUq e0; EpiPlain e1, e2;
    __device__ __forceinline__ void operator()(const f32x4 (&acc)[2][2][4][2], const Unit& u, int wr, int wc, int fr, int fq) const {
        if (u.gid == 0) e0(acc, u, wr, wc, fr, fq); else if (u.gid == 1) e1(acc, u, wr, wc, fr, fq); else e2(acc, u, wr, wc, fr, fq);
    }
};
struct EpiBrSb {
    static constexpr bool PERM = true, AFTER_DRAIN = false;
    float* T; const bf16_t* G; float* slab;
    __device__ __forceinline__ void operator()(const f32x4 (&acc)[2][2][4][2], const Unit& u, int wr, int wc, int fr, int fq) const {
        const int row0 = u.pm * BM + wr * 64 + fr, col0 = u.pn * BM + wc * 32 + 8 * fq; const bool part = u.chunk >= 0;
        float* Tb = part ? slab + ((size_t)u.chunk * NSAMPLE + (row0 - NPROMPT)) * DM : T + (size_t)row0 * DM;
        EPI_LOOP_AM { const int ro = ai * HALF + m * 16; const bf16_t* gp = G + (size_t)(row0 + ro) * 4096 + col0; float* tp = Tb + (size_t)ro * DM + col0;
#pragma unroll
            for (int bj = 0; bj < 2; ++bj) { f32x4 g0, g1; unpk8(*(const u32x4*)(gp + bj * HALF), g0, g1); if (part) { g0 = (f32x4){1.f, 1.f, 1.f, 1.f}; g1 = g0; }
                *(f32x4*)(tp + bj * HALF) = g0 * acc[ai][bj][m][0]; *(f32x4*)(tp + bj * HALF + 4) = g1 * acc[ai][bj][m][1]; } }
    }
};
struct EpiBrMla {
    static constexpr bool PERM = true, AFTER_DRAIN = false;
    const float* T; const bf16_t* G; bf16_t* MG; float* slab;
    __device__ __forceinline__ void operator()(const f32x4 (&acc)[2][2][4][2], const Unit& u, int wr, int wc, int fr, int fq) const {
        const int row0 = u.pm * BM + wr * 64 + fr, col0 = u.pn * BM + wc * 32 + 8 * fq;
        if (u.chunk >= 0) { float* sp = slab + ((size_t)u.chunk * NSAMPLE + (row0 - NPROMPT)) * DM + col0;
            EPI_LOOP_AM { float* tp = sp + (size_t)(ai * HALF + m * 16) * DM;
#pragma unroll
                for (int bj = 0; bj < 2; ++bj) { *(f32x4*)(tp + bj * HALF) = acc[ai][bj][m][0]; *(f32x4*)(tp + bj * HALF + 4) = acc[ai][bj][m][1]; } }
        } else
        EPI_LOOP_AM { const int row = row0 + ai * HALF + m * 16; const bf16_t* gp = G + (size_t)row * 4096 + 2048 + col0; const float* tp = T + (size_t)row * DM + col0; bf16_t* op = MG + (size_t)row * DM + col0;
#pragma unroll
            for (int bj = 0; bj < 2; ++bj) { f32x4 g0, g1; unpk8(*(const u32x4*)(gp + bj * HALF), g0, g1);
                const f32x4 t0 = *(const f32x4*)(tp + bj * HALF), t1 = *(const f32x4*)(tp + bj * HALF + 4);
                *(u32x4*)(op + bj * HALF) = pk8(t0 + g0 * acc[ai][bj][m][0], t1 + g1 * acc[ai][bj][m][1]); } }
    }
};
struct EpiP8 {
    static constexpr bool PERM = true, AFTER_DRAIN = false;
    EpiBrSb e0; EpiBrMla e1;
    __device__ __forceinline__ void operator()(const f32x4 (&acc)[2][2][4][2], const Unit& u, int wr, int wc, int fr, int fq) const {
        if (u.gid == 0) e0(acc, u, wr, wc, fr, fq); else e1(acc, u, wr, wc, fr, fq);
    }
};
template <class Epi, class Sched, bool ALIGN_EPI = false, bool SP2 = false>
__device__ __forceinline__ void gemm_phase(PG8_LAS unsigned char* lds, const Gemm g, const Sched& S, const Epi& E) {
    const int tid = threadIdx.x, wid = __builtin_amdgcn_readfirstlane(tid >> 6), lane = tid & 63, wr = wid >> 2, wc = wid & 3, fr = lane & 15, fq = lane >> 4;
    const int K = g.K;
    unsigned voffA[2], voffB[2];
#pragma unroll
    for (int i = 0; i < 2; ++i) { int R, C; stage_rc(tid * 16 + i * 8192, R, C); const int Rb = Epi::PERM ? ((R & ~31) + perm32(R & 31)) : R;
        voffA[i] = (unsigned)(R * K + C) * 2u; voffB[i] = (unsigned)(Rb * K + C) * 2u; }
    const size_t kstep = (size_t)(BK * 2);
    const size_t hstep = (size_t)HALF * K * 2;
    const size_t tstep = 2 * hstep;
    const unsigned ldsw = (unsigned)wid * 1024u;
    const int aoff = lds_byte(wr * 64 + fr, fq * 8), boff = lds_byte(wc * 32 + fr, fq * 8);
#define PG8_SA(b, h) (((b) * 2 + (h)) * HTB)
#define PG8_SB(b, h) ((4 + (b) * 2 + (h)) * HTB)
#define PG8_STAGE(bufoff, gbase, voff) do { _Pragma("unroll") for (int _i = 0; _i < 2; ++_i) \
        __builtin_amdgcn_global_load_lds((const unsigned*)((const char*)(gbase) + (voff)[_i]), (PG8_LAS unsigned*)(lds + (bufoff) + ldsw + _i * 8192), 16, 0, 0); } while (0)
#define PG8_LDA(dst, b, h) do { _Pragma("unroll") for (int m = 0; m < 4; ++m) _Pragma("unroll") for (int k = 0; k < 2; ++k) dst[m][k] = *(const PG8_LAS bf16x8*)(lds + PG8_SA(b, h) + aoff + m * 2048 + k * 1024); } while (0)
#define PG8_LDB(dst, b, h) do { _Pragma("unroll") for (int n = 0; n < 2; ++n) _Pragma("unroll") for (int k = 0; k < 2; ++k) dst[n][k] = *(const PG8_LAS bf16x8*)(lds + PG8_SB(b, h) + boff + n * 2048 + k * 1024); } while (0)
#define PG8_MMA(ai, bj, At, Bt) do { __builtin_amdgcn_s_setprio(1); _Pragma("unroll") for (int m = 0; m < 4; ++m) _Pragma("unroll") for (int n = 0; n < 2; ++n) _Pragma("unroll") for (int k = 0; k < 2; ++k) \
        acc[ai][bj][m][n] = __builtin_amdgcn_mfma_f32_16x16x32_bf16(Bt[n][k], At[m][k], acc[ai][bj][m][n], 0, 0, 0); __builtin_amdgcn_s_setprio(0); } while (0)
#define PG8_WAIT_V(n) asm volatile("s_waitcnt vmcnt(" #n ")" ::: "memory")
#define PG8_WAIT_L(n) asm volatile("s_waitcnt lgkmcnt(" #n ")" ::: "memory")
#define PG8_BAR __builtin_amdgcn_s_barrier()
#define PG8_SCHED __builtin_amdgcn_sched_barrier(0)
    Unit cur, nxt; int ui = 0;
    if (!S.next(0, cur)) return;
    f32x4 acc[2][2][4][2];
#pragma unroll
    for (int a = 0; a < 2; ++a)
#pragma unroll
        for (int b = 0; b < 2; ++b)
#pragma unroll
            for (int m = 0; m < 4; ++m)
#pragma unroll
                for (int n = 0; n < 2; ++n) acc[a][b][m][n] = (f32x4){0.f, 0.f, 0.f, 0.f};
    bf16x8 At[4][2], B0[2][2], B1[2][2];
#define PG8_GA(u_) ((const char*)g.A + ((u_).gid == 1 ? g.dA1 : ((u_).gid == 2 ? g.dA2 : 0L)))
#define PG8_GB(u_) ((const char*)g.Bt + ((u_).gid == 1 ? g.dB1 : ((u_).gid == 2 ? g.dB2 : 0L)))
    const char* cA = PG8_GA(cur) + (size_t)cur.pm * tstep + (size_t)cur.kofs * 2; const char* cB = PG8_GB(cur) + (size_t)cur.pn * tstep + (size_t)cur.kofs * 2;
    S.a_ready(cur);
    if constexpr (SP2) {
        PG8_STAGE(PG8_SB(0, 0), cB, voffB); PG8_STAGE(PG8_SB(0, 1), cB + hstep, voffB); PG8_STAGE(PG8_SA(0, 0), cA, voffA); PG8_STAGE(PG8_SA(0, 1), cA + hstep, voffA);
        if (wr == 1) PG8_BAR;
        PG8_WAIT_V(2); PG8_BAR;
        PG8_STAGE(PG8_SB(1, 0), cB + kstep, voffB); PG8_STAGE(PG8_SA(1, 0), cA + kstep, voffA); PG8_STAGE(PG8_SB(1, 1), cB + hstep + kstep, voffB);
        PG8_WAIT_V(6); PG8_BAR;
    } else {
        PG8_STAGE(PG8_SB(0, 0), cB, voffB); PG8_STAGE(PG8_SA(0, 0), cA, voffA); PG8_STAGE(PG8_SB(0, 1), cB + hstep, voffB); PG8_STAGE(PG8_SA(0, 1), cA + hstep, voffA);
        if (wr == 1) PG8_BAR;
        PG8_WAIT_V(4); PG8_BAR;
        PG8_STAGE(PG8_SB(1, 0), cB + kstep, voffB); PG8_STAGE(PG8_SA(1, 0), cA + kstep, voffA); PG8_STAGE(PG8_SB(1, 1), cB + hstep + kstep, voffB);
        PG8_WAIT_V(6); PG8_BAR;
    }
    for (;;) {
        const bool has_next = S.next(ui + 1, nxt);
        const char* nA = has_next ? PG8_GA(nxt) + (size_t)nxt.pm * tstep + (size_t)nxt.kofs * 2 : cA; const char* nB = has_next ? PG8_GB(nxt) + (size_t)nxt.pn * tstep + (size_t)nxt.kofs * 2 : cB;
        const int nt = cur.nt;
        for (int t = 0; t < nt; t += 2) {
            const bool last = (t == nt - 2);
            const char* a1 = cA + (size_t)(t + 1) * kstep;
            const char* a2 = last ? nA : cA + (size_t)(t + 2) * kstep; const char* b2 = last ? nB : cB + (size_t)(t + 2) * kstep;
            const char* a3 = a2 + kstep; const char* b3 = b2 + kstep;
            if (last && has_next) S.a_ready(nxt);
            if constexpr (SP2) {
            PG8_LDB(B0, 0, 0); PG8_LDB(B1, 0, 1); PG8_SCHED; PG8_LDA(At, 0, 0); PG8_STAGE(PG8_SA(1, 1), a1 + hstep, voffA);
            PG8_WAIT_V(8); PG8_WAIT_L(0); PG8_BAR; PG8_MMA(0, 0, At, B0); PG8_MMA(0, 1, At, B1); PG8_BAR; PG8_SCHED;
            PG8_LDA(At, 0, 1); PG8_STAGE(PG8_SB(0, 0), b2, voffB); PG8_STAGE(PG8_SB(0, 1), b2 + hstep, voffB); PG8_STAGE(PG8_SA(0, 0), a2, voffA);
            PG8_WAIT_V(8); PG8_WAIT_L(0); PG8_BAR; PG8_MMA(1, 0, At, B0); PG8_MMA(1, 1, At, B1); PG8_BAR; PG8_SCHED;
            PG8_LDB(B0, 1, 0); PG8_LDB(B1, 1, 1); PG8_SCHED; PG8_LDA(At, 1, 0); PG8_STAGE(PG8_SA(0, 1), a2 + hstep, voffA);
            PG8_WAIT_V(8); PG8_WAIT_L(0); PG8_BAR; PG8_MMA(0, 0, At, B0); PG8_MMA(0, 1, At, B1); PG8_BAR; PG8_SCHED;
            PG8_LDA(At, 1, 1); PG8_STAGE(PG8_SB(1, 0), b3, voffB); PG8_STAGE(PG8_SB(1, 1), b3 + hstep, voffB); PG8_STAGE(PG8_SA(1, 0), a3, voffA);
            PG8_WAIT_V(8); PG8_WAIT_L(0); PG8_BAR; PG8_MMA(1, 0, At, B0); PG8_MMA(1, 1, At, B1); PG8_BAR; PG8_SCHED;
            } else {
            PG8_LDB(B0, 0, 0); PG8_SCHED; PG8_LDA(At, 0, 0); PG8_STAGE(PG8_SA(1, 1), a1 + hstep, voffA);
            PG8_WAIT_L(8); PG8_BAR; PG8_WAIT_L(0); PG8_MMA(0, 0, At, B0); PG8_BAR; PG8_SCHED;
            PG8_LDB(B1, 0, 1); PG8_STAGE(PG8_SB(0, 0), b2, voffB);
            PG8_BAR; PG8_WAIT_L(0); PG8_MMA(0, 1, At, B1); PG8_BAR;
            PG8_LDA(At, 0, 1); PG8_STAGE(PG8_SA(0, 0), a2, voffA);
            PG8_BAR; PG8_WAIT_L(0); PG8_MMA(1, 0, At, B0); PG8_BAR; PG8_SCHED;
            PG8_STAGE(PG8_SB(0, 1), b2 + hstep, voffB);
            PG8_WAIT_V(6); PG8_BAR; PG8_MMA(1, 1, At, B1); PG8_BAR;
            PG8_LDB(B0, 1, 0); PG8_SCHED; PG8_LDA(At, 1, 0); PG8_STAGE(PG8_SA(0, 1), a2 + hstep, voffA);
            PG8_WAIT_L(8); PG8_BAR; PG8_WAIT_L(0); PG8_MMA(0, 0, At, B0); PG8_BAR; PG8_SCHED;
            PG8_LDB(B1, 1, 1); PG8_STAGE(PG8_SB(1, 0), b3, voffB);
            PG8_BAR; PG8_WAIT_L(0); PG8_MMA(0, 1, At, B1); PG8_BAR;
            PG8_LDA(At, 1, 1); PG8_STAGE(PG8_SA(1, 0), a3, voffA);
            PG8_BAR; PG8_WAIT_L(0); PG8_MMA(1, 0, At, B0); PG8_BAR; PG8_SCHED;
            PG8_STAGE(PG8_SB(1, 1), b3 + hstep, voffB);
            PG8_WAIT_V(6); PG8_BAR; PG8_MMA(1, 1, At, B1); PG8_BAR;
            }
        }
        if constexpr (ALIGN_EPI) { if (wr == 0) PG8_BAR; }
        if constexpr (!Epi::AFTER_DRAIN) { E(acc, cur, wr, wc, fr, fq); S.done(cur); }
        if (!has_next) break;
#pragma unroll
        for (int a = 0; a < 2; ++a)
#pragma unroll
            for (int b = 0; b < 2; ++b)
#pragma unroll
                for (int m = 0; m < 4; ++m)
#pragma unroll
                    for (int n = 0; n < 2; ++n) acc[a][b][m][n] = (f32x4){0.f, 0.f, 0.f, 0.f};
        cur = nxt; cA = nA; cB = nB; ++ui;
        if constexpr (ALIGN_EPI) { if (wr == 1) PG8_BAR; }
    }
    PG8_WAIT_V(0);
    if constexpr (!ALIGN_EPI) { if (wr == 0) PG8_BAR; }
    PG8_BAR;
    if constexpr (Epi::AFTER_DRAIN) { E.fused(acc, cur, wr, wc, fr, fq, lds, wid, lane); S.done(cur); }
#undef PG8_GA
#undef PG8_GB
#undef PG8_SA
#undef PG8_SB
#undef PG8_STAGE
#undef PG8_LDA
#undef PG8_LDB
#undef PG8_MMA
#undef PG8_WAIT_V
#undef PG8_WAIT_L
#undef PG8_BAR
#undef PG8_SCHED
}
}

using pg8::bf16_t; using pg8::bf16x8; using pg8::f32x4; using pg8::u32x4; using pg8::pk2; using pg8::pk8;
typedef float f32x16 __attribute__((ext_vector_type(16)));
typedef unsigned u32x2 __attribute__((ext_vector_type(2)));
constexpr int NWAVES = 8;
#define GAS __attribute__((address_space(1)))
#define LAS __attribute__((address_space(3)))
typedef GAS unsigned gu32;
#define RLX_AGENT __ATOMIC_RELAXED, __HIP_MEMORY_SCOPE_AGENT
#define LDS_WAIT() asm volatile("s_waitcnt lgkmcnt(0)" ::: "memory")
#define VM_WAIT() asm volatile("s_waitcnt vmcnt(0)" ::: "memory")

constexpr size_t MiB = 1u << 20;
constexpr size_t WS_CTL = 0, CTL_ZERO_BYTES = 1 * MiB;
constexpr size_t WS_TAB = 1 * MiB;
constexpr size_t WS_W1I = 2 * MiB;
constexpr size_t WS_W1O = WS_W1I + (size_t)2 * FF * DM * 2;
constexpr size_t WS_KN  = WS_W1I;
constexpr size_t WS_HB  = WS_W1O + (size_t)DM * FF * 2;
constexpr size_t WS_WIN = WS_HB + (size_t)MTOK * DM * 2;
constexpr size_t WS_WUQ = WS_WIN + (size_t)NIN * DM * 2;
constexpr size_t WS_WKV = WS_WUQ + (size_t)1536 * 512 * 2;
constexpr size_t WS_WBS = WS_WKV + (size_t)2048 * 512 * 2;
constexpr size_t WS_WBM = WS_WBS + (size_t)DM * 1024 * 2;
constexpr size_t WS_WO  = WS_WBM + (size_t)DM * 1024 * 2;
constexpr size_t WS_W2I = WS_WO + (size_t)DM * DM * 2;
constexpr size_t WS_W2O = WS_W2I + (size_t)2 * FF * DM * 2;
constexpr size_t WS_ACT = WS_W2O + (size_t)DM * FF * 2;
constexpr size_t WS_G   = WS_ACT;
constexpr size_t WS_Y   = WS_ACT + (size_t)MTOK * FF * 2;
constexpr size_t WS_VT  = WS_Y;
constexpr size_t WS_T   = WS_Y;
constexpr size_t WS_H   = WS_Y + (size_t)MTOK * DM * 4;
constexpr size_t WS_QM  = WS_H;
constexpr size_t WS_QS  = WS_H + (size_t)MTOK * DM * 4;
constexpr size_t WS_CQ  = WS_QS + (size_t)MTOK * 1024 * 2;
constexpr size_t WS_CKV = WS_CQ + (size_t)MTOK * 512 * 4;
constexpr size_t WS_KR  = WS_CKV + (size_t)MTOK * 512 * 4;
constexpr size_t WS_OSB = WS_CQ;
constexpr size_t WS_OML = WS_OSB + (size_t)MTOK * 1024 * 2;
constexpr size_t WS_CKA = WS_KR + (size_t)MTOK * 64 * 4;
constexpr size_t WS_CQB = WS_CKA + (size_t)KROWS * 512 * 2;
constexpr size_t WS_MG  = WS_CKA;
constexpr size_t WS_KRB = WS_CKA + (size_t)MTOK * DM * 2;
constexpr size_t WS_END = WS_KRB + (size_t)NPROMPT * 64 * 2;
static_assert(WS_OML + (size_t)MTOK * 1024 * 2 <= WS_CKA && WS_CQB + (size_t)MTOK * 512 * 2 <= WS_KRB && WS_KN + (size_t)(KROWS + 32) * 1024 * 2 <= WS_HB && WS_VT + (size_t)1024 * VPITCH * 2 <= WS_H, "d_ws map");
static_assert(WS_KN + (size_t)16 * NSAMPLE * DM * 4 <= WS_HB && WS_CQ + (size_t)32 * NSAMPLE * DM * 4 <= WS_KRB && WS_CQ + (size_t)16 * NSAMPLE * DM * 4 <= WS_CKA, "split-K slabs");
static_assert(WS_END <= (size_t)600 * MiB && (WS_W1O % 256) == 0 && (WS_CKA % 256) == 0 && (WS_CQB % 256) == 0, "d_ws map");
constexpr size_t O_YP = 0, O_YS = 16777216, O_KP = 17301504, O_VP = 25690112, O_CKVP = 34078720, O_KRP = 38273024, O_KS = 38797312, O_VS = 39059456, O_CKVS = 39321600, O_KRS = 39452672, O_END = 39469056;
constexpr int CW_TMO = 0, CW_BAR = 4096;
constexpr int RING_BYTES = 131072, LDSCTL_OFF = RING_BYTES, MISC_OFF = LDSCTL_OFF + 320, LDS_BYTES = 147456;
#define XB_TMO      128
#define XB_XCNT(j)  (256  + 64 * (j))
#define XB_XSUB(j)  (1280 + 64 * (j))
#define XB_XGEN(j)  (2304 + 64 * (j))
#define XB_TOP      3328
#define XB_TOPGEN   3392
#define XCD_BAR_WORDS 3456
#define XB_SPIN_CAP (1u << 18)

__device__ __forceinline__ unsigned xb_ld(unsigned* p)              { return __hip_atomic_load(p, __ATOMIC_RELAXED, __HIP_MEMORY_SCOPE_AGENT); }
__device__ __forceinline__ unsigned xb_add(unsigned* p, unsigned v) { return __hip_atomic_fetch_add(p, v, __ATOMIC_RELAXED, __HIP_MEMORY_SCOPE_AGENT); }
__device__ __forceinline__ unsigned xb_xcc_id() { return (unsigned)__builtin_amdgcn_s_getreg((3 << 11) | 20) & 0xFu; }
#define XB_SPIN(cond, bar) do { unsigned _sp = 0; while (cond) { __builtin_amdgcn_s_sleep(1); \
    if ((++_sp & 255u) == 0u) { if (xb_ld(&(bar)[XB_TMO])) break; if (_sp > XB_SPIN_CAP) { atomicAdd(&(bar)[XB_TMO], 1u); break; } } } } while (0)

struct XcdBarrier {
    unsigned* bar; unsigned x;
    volatile LAS unsigned* st;
};

__device__ __forceinline__ XcdBarrier xcd_barrier_post(unsigned* bar, volatile LAS unsigned* st) {
    XcdBarrier b; b.bar = bar; b.x = xb_xcc_id(); b.st = st;
    if (threadIdx.x == 0) (void)xb_add(&bar[XB_XCNT(b.x)], 1u);
    return b;
}
__device__ __forceinline__ void xcd_barrier_complete(unsigned* bar, unsigned x, unsigned& nloc, unsigned& nx) {
    const unsigned G = gridDim.x * gridDim.y * gridDim.z;
    unsigned sum, cnt, mine, sp = 0u;
    for (;;) {
        sum = 0u; cnt = 0u; mine = 0u;
#pragma unroll
        for (unsigned j = 0; j < 16; ++j) { const unsigned c = xb_ld(&bar[XB_XCNT(j)]); sum += c; cnt += (c > 0u) ? 1u : 0u; mine = (j == x) ? c : mine; }
        if (sum == G) break;
        __builtin_amdgcn_s_sleep(1);
        if ((++sp & 255u) == 0u) { if (xb_ld(&bar[XB_TMO])) break; if (sp > XB_SPIN_CAP) { atomicAdd(&bar[XB_TMO], 1u); break; } }
    }
    nloc = mine > 0u ? mine : 1u; nx = cnt > 0u ? cnt : 1u;
}

__device__ __forceinline__ void xcd_barrier(const XcdBarrier& b) {
    asm volatile("s_waitcnt vmcnt(0)" ::: "memory");
    __syncthreads();
    if (threadIdx.x == 0) {
        unsigned* bar = b.bar;
        __builtin_amdgcn_s_waitcnt(0);
        unsigned nloc = b.st[0], nx = b.st[1];
        if (nloc == 0u) { xcd_barrier_complete(bar, b.x, nloc, nx); b.st[0] = nloc; b.st[1] = nx; }
        const unsigned old = xb_add(&bar[XB_XSUB(b.x)], 1u);
        const unsigned gen = old / nloc;
        if (old + 1u == (gen + 1u) * nloc) {
            __builtin_amdgcn_fence(__ATOMIC_RELEASE, "agent");
            asm volatile("s_waitcnt vmcnt(0)" ::: "memory");
            const unsigned og = xb_add(&bar[XB_TOP], 1u);
            const unsigned tg = og / nx;
            if (og + 1u == (tg + 1u) * nx) xb_add(&bar[XB_TOPGEN], 1u);
            else XB_SPIN(xb_ld(&bar[XB_TOPGEN]) == tg, bar);
            __builtin_amdgcn_fence(__ATOMIC_ACQUIRE, "agent");
            xb_add(&bar[XB_XGEN(b.x)], 1u);
            asm volatile("s_waitcnt vmcnt(0)" ::: "memory");
        } else {
            XB_SPIN(xb_ld(&bar[XB_XGEN(b.x)]) == gen, bar);
            __builtin_amdgcn_fence(__ATOMIC_ACQUIRE, "agent");
            asm volatile("s_waitcnt vmcnt(0)" ::: "memory");
        }
    }
    __syncthreads();
}

__device__ __forceinline__ float wave_sum(float v) {
#pragma unroll
    for (int o = 1; o < 64; o <<= 1) v += __shfl_xor(v, o);
    return v;
}
__device__ __forceinline__ void transpose_item(const float* W, int ldw, int k0, int n0, bf16_t* WT, int ldt, int drow0, LAS float* scr, int lane) {
#pragma unroll 8
    for (int i = 0; i < 32; ++i) { const int kk = 2 * i + (lane >> 5); scr[kk * 33 + (lane & 31)] = W[(size_t)(k0 + kk) * ldw + n0 + (lane & 31)]; }
    LDS_WAIT(); asm volatile("" ::: "memory");
    const int c = lane & 7;
#pragma unroll
    for (int j = 0; j < 4; ++j) { const int n = (lane >> 3) + 8 * j; const LAS float* s = scr + (8 * c) * 33 + n;
        u32x4 o; o.x = pk2(s[0 * 33], s[1 * 33]); o.y = pk2(s[2 * 33], s[3 * 33]); o.z = pk2(s[4 * 33], s[5 * 33]); o.w = pk2(s[6 * 33], s[7 * 33]);
        *(u32x4*)(WT + (size_t)(drow0 + n) * ldt + k0 + 8 * c) = o; }
    LDS_WAIT(); asm volatile("" ::: "memory");
}
template <int MAP> __device__ __forceinline__ int map_row(int n0) {
    if (MAP == 1) { const int j = n0 < FF ? n0 : n0 - FF; return ((j >> 7) << 8) + (j & 127) + (n0 < FF ? 0 : 128); }
    if (MAP == 2) { return n0 < 4096 ? n0 : (n0 < 4160 ? 8192 + (n0 - 4096) : 4096 + (n0 - 4160)); }
    if (MAP == 3) { const int h = n0 >> 8, r = n0 & 255; return r < 128 ? h * 128 + r : 1024 + h * 128 + (r - 128); }
    return n0;
}
template <int MAP> __device__ __forceinline__ void transpose_matrix(const float* W, int K, int N, bf16_t* WT, LAS float* scr, int gw, int NGW, int lane) {
    const int nnb = N / 32, nit = (K / 64) * nnb;
    for (int it = gw; it < nit; it += NGW) { const int kb = it / nnb, nb = it - kb * nnb; transpose_item(W, N, kb * 64, nb * 32, WT, K, map_row<MAP>(nb * 32), scr, lane); }
}
__device__ __forceinline__ int tok_pos(int m) { return m < NPROMPT ? (m & (SEQ - 1)) : PAST + ((m - NPROMPT) & (DEC_T - 1)); }
__device__ __forceinline__ int tok_krow(int m) { return m < NPROMPT ? m : NPROMPT + ((m - NPROMPT) >> 4) * KEYS_S + PAST + ((m - NPROMPT) & 15); }

__device__ __forceinline__ void ln_row_finish(f32x4 (&v)[8], const float* gam, const float* bet, float* frow, bf16_t* brow, int lane) {
    float s = 0.f;
#pragma unroll
    for (int j = 0; j < 8; ++j) s += (v[j][0] + v[j][1]) + (v[j][2] + v[j][3]);
    const float mean = wave_sum(s) * (1.f / DM); float s2 = 0.f;
#pragma unroll
    for (int j = 0; j < 8; ++j) { v[j] = v[j] - mean; s2 += (v[j][0] * v[j][0] + v[j][1] * v[j][1]) + (v[j][2] * v[j][2] + v[j][3] * v[j][3]); }
    const float rstd = 1.f / sqrtf(wave_sum(s2) * (1.f / DM) + LN_EPS);
    f32x4* fo = (f32x4*)frow + lane; u32x2* bo = (u32x2*)brow + lane;
#pragma unroll
    for (int j = 0; j < 8; ++j) { const f32x4 g = ((const f32x4*)gam)[64 * j + lane], b = ((const f32x4*)bet)[64 * j + lane]; const f32x4 o = v[j] * rstd * g + b;
        if (frow) fo[64 * j] = o; if (brow) { u32x2 w; w.x = pk2(o[0], o[1]); w.y = pk2(o[2], o[3]); bo[64 * j] = w; } }
}
template <int NCH, bool RBF>
__device__ __forceinline__ void ln_phase(LAS unsigned char* lds, const bf16_t* Y, const float* gam, const float* bet, float* F0, float* F1, bf16_t* HBo, const float* slab, const void* R1, float alpha, float sc, int bx, int G, int tid, int wave, int lane) {
    const int gw = bx * NWAVES + wave, NGW = G * NWAVES;
    for (int sr = bx; sr < NSAMPLE; sr += G) {
        const f32x4* sp = (const f32x4*)(slab + (size_t)sr * DM) + tid;
        f32x4 a = sp[0];
#pragma unroll 8
        for (int c = 1; c < NCH; ++c) a += sp[(size_t)c * (NSAMPLE * DM / 4)];
        f32x4 rr;
        if (RBF) { const u32x2 w = ((const u32x2*)((const bf16_t*)R1 + (size_t)sr * DM))[tid]; rr = (f32x4){pg8::bf_lo(w.x), pg8::bf_hi(w.x), pg8::bf_lo(w.y), pg8::bf_hi(w.y)}; }
        else rr = ((const f32x4*)((const float*)R1 + (size_t)sr * DM))[tid];
        ((LAS f32x4*)lds)[tid] = rr * alpha + a * sc;
        __syncthreads();
        if (wave == 0) { f32x4 v[8];
#pragma unroll
            for (int j = 0; j < 8; ++j) v[j] = ((const LAS f32x4*)lds)[64 * j + lane];
            ln_row_finish(v, gam, bet, F1 ? F1 + (size_t)sr * DM : nullptr, HBo ? HBo + (size_t)(NPROMPT + sr) * DM : nullptr, lane); }
        __syncthreads();
    }
    for (int m = gw; m < NPROMPT; m += NGW) {
        const u32x2* yr = (const u32x2*)(Y + (size_t)m * DM) + lane; f32x4 v[8];
#pragma unroll
        for (int j = 0; j < 8; ++j) { const u32x2 w = yr[64 * j]; v[j] = (f32x4){pg8::bf_lo(w.x), pg8::bf_hi(w.x), pg8::bf_lo(w.y), pg8::bf_hi(w.y)}; }
        ln_row_finish(v, gam, bet, F0 ? F0 + (size_t)m * DM : nullptr, HBo ? HBo + (size_t)m * DM : nullptr, lane);
    }
}

#define MFMA32(a, b, c) __builtin_amdgcn_mfma_f32_32x32x16_bf16((a), (b), (c), 0, 0, 0)
__device__ __forceinline__ bf16x8 pack8f(const f32x4 a, const f32x4 b) { return __builtin_bit_cast(bf16x8, pk8(a, b)); }
__device__ __forceinline__ int pi32(int r) { return (r & ~12) | ((r & 4) << 1) | ((r & 8) >> 1); }
__device__ __forceinline__ void store_ot(bf16_t* op, const f32x16 (&o)[4], float sc, int hi) {
#pragma unroll
    for (int dt = 0; dt < 4; ++dt)
#pragma unroll
        for (int g = 0; g < 4; ++g) { u32x2 w; w.x = pk2(o[dt][4 * g] * sc, o[dt][4 * g + 1] * sc); w.y = pk2(o[dt][4 * g + 2] * sc, o[dt][4 * g + 3] * sc);
            *(u32x2*)(op + dt * 32 + 8 * g + 4 * hi) = w; }
}

__device__ __forceinline__ void sb_scores(const bf16x8 (&kf)[8], const bf16x8 (&qf)[8], bool diag, int key0, int qpos, int hi, float& R, bf16x8& pf0, bf16x8& pf1) {
    f32x16 st;
#pragma unroll
    for (int i = 0; i < 16; ++i) st[i] = 0.f;
#pragma unroll
    for (int ks = 0; ks < 8; ++ks) st = MFMA32(kf[ks], qf[ks], st);
    float l1[16], lb[16];
#pragma unroll
    for (int i = 0; i < 16; ++i) { const float zz = st[i]; const float e = __builtin_amdgcn_exp2f(-__builtin_fabsf(zz)); const float sp = fmaxf(zz, 0.f) + __builtin_amdgcn_logf(1.f + e);
        l1[i] = -sp; lb[i] = zz - sp;
        if (diag) { const int key = key0 + 16 * (i >> 3) + 8 * hi + (i & 7); const bool vis = key < qpos; l1[i] = vis ? l1[i] : 0.f; lb[i] = vis ? lb[i] : -INFINITY; } }
    float g0 = 0.f, g1 = 0.f;
#pragma unroll
    for (int i = 0; i < 8; ++i) { g0 += l1[i]; g1 += l1[8 + i]; }
    const float pg0 = __shfl_xor(g0, 32), pg1 = __shfl_xor(g1, 32);
    float p[16];
    { float run = R + (hi ? 0.f : pg1);
#pragma unroll
      for (int i = 15; i >= 8; --i) { p[i] = __builtin_amdgcn_exp2f(lb[i] + run); run += l1[i]; }
      run = R + g1 + pg1 + (hi ? 0.f : pg0);
#pragma unroll
      for (int i = 7; i >= 0; --i) { p[i] = __builtin_amdgcn_exp2f(lb[i] + run); run += l1[i]; } }
    R += (g0 + g1) + (pg0 + pg1);
    pf0 = pack8f((f32x4){p[0], p[1], p[2], p[3]}, (f32x4){p[4], p[5], p[6], p[7]}); pf1 = pack8f((f32x4){p[8], p[9], p[10], p[11]}, (f32x4){p[12], p[13], p[14], p[15]});
}
constexpr int SK_PITCH = 272, SV_PITCH = 136, SK_BYTES = 64 * SK_PITCH, SV_BYTES = 128 * SV_PITCH, ST_BYTES = SK_BYTES + SV_BYTES;
static_assert(2 * ST_BYTES + 64 <= RING_BYTES && 8 * 32 * 4 + 9 * 64 * 32 * 4 <= RING_BYTES, "SB LDS");
__device__ __forceinline__ void sb_prompt_unit(LAS unsigned char* lds, int b, int h, int j, const bf16_t* QS, const float* Kp, const float* Vp, bf16_t* OSB, int tid, int lane, int wave) {
    const int r = lane & 31, hi = lane >> 5;
    const int Q0 = j * 256, qpos = Q0 + 32 * wave + r, qrow = b * SEQ + qpos, NT = (Q0 + 256) / 64;
    const bf16_t* qp = QS + (size_t)qrow * 1024 + h * 128 + 8 * hi;
    bf16x8 qf[8];
#pragma unroll
    for (int ks = 0; ks < 8; ++ks) qf[ks] = *(const bf16x8*)(qp + 16 * ks);
    f32x16 o[4];
#pragma unroll
    for (int dt = 0; dt < 4; ++dt)
#pragma unroll
        for (int i = 0; i < 16; ++i) o[dt][i] = 0.f;
    float R = 0.f; int done = 0;
    volatile LAS int* flags = (volatile LAS int*)(lds + 2 * ST_BYTES);
    const float* gK = Kp + (size_t)(b * SEQ) * 1024 + h * 128;
    const float* gV = Vp + (size_t)(b * SEQ) * 1024 + h * 128;
    f32x4 ka[2][2]; float va[8][2];
#define SB_ISSUE(t) do { const int kb_ = Q0 + 256 - 64 * ((t) + 1); \
        _Pragma("unroll") for (int jj = 0; jj < 2; ++jj) { const int idx = tid + 512 * jj; const float* p_ = gK + (size_t)(kb_ + (idx >> 4)) * 1024 + (idx & 15) * 8; ka[jj][0] = *(const f32x4*)p_; ka[jj][1] = *(const f32x4*)(p_ + 4); } \
        _Pragma("unroll") for (int jj = 0; jj < 8; ++jj) { const int idx = tid + 512 * jj; const float* p_ = gV + (size_t)(kb_ + 2 * (idx >> 7)) * 1024 + (idx & 127); va[jj][0] = p_[0]; va[jj][1] = p_[1024]; } } while (0)
#define SB_COMMIT(buf) do { LAS unsigned char* B_ = lds + (buf) * ST_BYTES; \
        _Pragma("unroll") for (int jj = 0; jj < 2; ++jj) { const int idx = tid + 512 * jj; *(LAS u32x4*)(B_ + (idx >> 4) * SK_PITCH + (idx & 15) * 16) = pk8(ka[jj][0], ka[jj][1]); } \
        _Pragma("unroll") for (int jj = 0; jj < 8; ++jj) { const int idx = tid + 512 * jj; *(LAS unsigned*)(B_ + SK_BYTES + (idx & 127) * SV_PITCH + (idx >> 7) * 4) = pk2(va[jj][0], va[jj][1]); } } while (0)
    const int pr = pi32(r);
    SB_ISSUE(0); SB_COMMIT(0); __syncthreads();
    for (int t = 0; t < NT; ++t) {
        if (t + 1 < NT) SB_ISSUE(t + 1);
        const int kbase = Q0 + 256 - 64 * (t + 1);
        const LAS unsigned char* Bt = lds + (t & 1) * ST_BYTES;
#pragma unroll
        for (int sub = 1; sub >= 0; --sub) {
            const int key0 = kbase + 32 * sub;
            if (!done && key0 <= Q0 + 32 * wave) {
                bf16x8 kf[8];
                { const LAS unsigned char* kp = Bt + (32 * sub + pr) * SK_PITCH + hi * 16;
#pragma unroll
                  for (int ks = 0; ks < 8; ++ks) kf[ks] = *(const LAS bf16x8*)(kp + ks * 32); }
                bf16x8 pf0, pf1; sb_scores(kf, qf, key0 == Q0 + 32 * wave, key0, qpos, hi, R, pf0, pf1);
                const LAS unsigned char* vp = Bt + SK_BYTES + r * SV_PITCH + (32 * sub + 8 * hi) * 2;
#pragma unroll
                for (int dt = 0; dt < 4; ++dt) {
                    const u32x2 a0 = *(const LAS u32x2*)(vp + dt * 32 * SV_PITCH), a1 = *(const LAS u32x2*)(vp + dt * 32 * SV_PITCH + 8), c0 = *(const LAS u32x2*)(vp + dt * 32 * SV_PITCH + 32), c1 = *(const LAS u32x2*)(vp + dt * 32 * SV_PITCH + 40);
                    o[dt] = MFMA32(__builtin_bit_cast(bf16x8, (u32x4){a0.x, a0.y, a1.x, a1.y}), pf0, o[dt]); o[dt] = MFMA32(__builtin_bit_cast(bf16x8, (u32x4){c0.x, c0.y, c1.x, c1.y}), pf1, o[dt]); }
                if (__all(R < -160.f)) done = 1;
            }
        }
        if (lane == 0) flags[(t & 1) * 8 + wave] = done;
        if (t + 1 < NT) SB_COMMIT((t + 1) & 1);
        __syncthreads();
        int alld = 1;
#pragma unroll
        for (int w = 0; w < 8; ++w) alld &= flags[(t & 1) * 8 + w];
        if (alld) break;
    }
#undef SB_ISSUE
#undef SB_COMMIT
    store_ot(OSB + (size_t)qrow * 1024 + h * 128, o, 1.f, hi);
    __syncthreads();
}
__device__ __forceinline__ void sb_sample_unit(LAS unsigned char* lds, int b, int h, const bf16_t* QS, const float* cK, const float* cV, const float* nK, const float* nV, bf16_t* OSB, int lane, int wave) {
    const int r = lane & 31, hi = lane >> 5;
    const int qi = r < DEC_T ? r : DEC_T - 1, qpos = PAST + qi, qrow = NPROMPT + b * DEC_T + qi, cl = hi * 16 + (r & 15);
    const bool valid = r < DEC_T;
    const bf16_t* qp = QS + (size_t)qrow * 1024 + h * 128 + 8 * hi;
    bf16x8 qf[8];
#pragma unroll
    for (int ks = 0; ks < 8; ++ks) qf[ks] = *(const bf16x8*)(qp + 16 * ks);
    float Rcarry = 0.f;
    LAS float* RT = (LAS float*)lds;
    LAS float* OP = (LAS float*)(lds + 8 * 32 * 4);
    LAS float* OA = OP + 8 * 64 * 32;
    if (wave == 0 && valid) {
#pragma unroll
        for (int i = 0; i < 64; ++i) OA[i * 32 + cl] = 0.f; }
    const int pr = pi32(r);
    for (int base = PAST / 32; base >= 0; base -= NWAVES) {
        const int kt = base - wave;
        f32x16 o[4];
#pragma unroll
        for (int dt = 0; dt < 4; ++dt)
#pragma unroll
            for (int i = 0; i < 16; ++i) o[dt][i] = 0.f;
        float Rl = 0.f;
        if (kt >= 0) {
            const float* Kb; const float* Vb; int nvalid = 32;
            if (kt < PAST / 32) { const size_t off = ((size_t)b * PAST + kt * 32) * 1024 + h * 128; Kb = cK + off; Vb = cV + off; }
            else { const size_t off = (size_t)(b * DEC_T) * 1024 + h * 128; Kb = nK + off; Vb = nV + off; nvalid = DEC_T; }
            bf16x8 kf[8];
            { const float* kr = Kb + (size_t)(pr < nvalid ? pr : nvalid - 1) * 1024 + 8 * hi;
#pragma unroll
              for (int ks = 0; ks < 8; ++ks) kf[ks] = pack8f(*(const f32x4*)(kr + 16 * ks), *(const f32x4*)(kr + 16 * ks + 4)); }
            bf16x8 pf0, pf1; sb_scores(kf, qf, kt == PAST / 32, kt * 32, qpos, hi, Rl, pf0, pf1);
#pragma unroll
            for (int s2 = 0; s2 < 2; ++s2) { float vv[4][8];
#pragma unroll
                for (int jj = 0; jj < 8; ++jj) { const int kl = 16 * s2 + 8 * hi + jj; const float* vp = Vb + (size_t)(kl < nvalid ? kl : nvalid - 1) * 1024 + r;
#pragma unroll
                    for (int dt = 0; dt < 4; ++dt) vv[dt][jj] = vp[32 * dt]; }
#pragma unroll
                for (int dt = 0; dt < 4; ++dt) o[dt] = MFMA32(pack8f((f32x4){vv[dt][0], vv[dt][1], vv[dt][2], vv[dt][3]}, (f32x4){vv[dt][4], vv[dt][5], vv[dt][6], vv[dt][7]}), s2 ? pf1 : pf0, o[dt]); }
        }
        if (valid) RT[wave * 32 + cl] = Rl;
        __syncthreads();
        float Rpre = Rcarry, Rall = Rcarry;
#pragma unroll
        for (int w = 0; w < NWAVES; ++w) { const float x = RT[w * 32 + cl]; Rall += x; Rpre += (w < wave) ? x : 0.f; }
        const float sc = __builtin_amdgcn_exp2f(Rpre);
        if (valid) {
#pragma unroll
            for (int dt = 0; dt < 4; ++dt)
#pragma unroll
                for (int i = 0; i < 16; ++i) OP[(wave * 64 + dt * 16 + i) * 32 + cl] = o[dt][i] * sc; }
        __syncthreads();
        if (wave == 0 && valid) {
#pragma unroll 4
            for (int i = 0; i < 64; ++i) { float a = OA[i * 32 + cl];
#pragma unroll
                for (int w = 0; w < NWAVES; ++w) a += OP[(w * 64 + i) * 32 + cl];
                OA[i * 32 + cl] = a; } }
        Rcarry = Rall;
        __syncthreads();
        if (__all(Rcarry < -160.f)) break;
    }
    if (wave == 0 && valid) { f32x16 oacc[4];
#pragma unroll
        for (int dt = 0; dt < 4; ++dt)
#pragma unroll
            for (int i = 0; i < 16; ++i) oacc[dt][i] = OA[(dt * 16 + i) * 32 + cl];
        store_ot(OSB + (size_t)qrow * 1024 + h * 128, oacc, 1.f, hi); }
    __syncthreads();
}

__device__ __forceinline__ void mla_softmax_pv_prep(const f32x16& st, f32x16 (&o)[4], float& mrun, float& lsum, bf16x8& pf0, bf16x8& pf1) {
    float mx = st[0];
#pragma unroll
    for (int i = 1; i < 16; ++i) mx = fmaxf(mx, st[i]);
    mx = fmaxf(mx, __shfl_xor(mx, 32));
    if (!__all(mx - mrun <= 6.f)) { const float mnew = fmaxf(mrun, mx), alpha = __builtin_amdgcn_exp2f(mrun - mnew); lsum *= alpha; mrun = mnew;
#pragma unroll
        for (int dt = 0; dt < 4; ++dt)
#pragma unroll
            for (int i = 0; i < 16; ++i) o[dt][i] *= alpha; }
    float p[16], ps = 0.f;
#pragma unroll
    for (int i = 0; i < 16; ++i) { p[i] = __builtin_amdgcn_exp2f(st[i] - mrun); ps += p[i]; }
    lsum += ps;
    pf0 = pack8f((f32x4){p[0], p[1], p[2], p[3]}, (f32x4){p[4], p[5], p[6], p[7]}); pf1 = pack8f((f32x4){p[8], p[9], p[10], p[11]}, (f32x4){p[12], p[13], p[14], p[15]});
}
constexpr int MK_PITCH = 400, MV_PITCH = 144, MK_BYTES = 64 * MK_PITCH, MV_BYTES = 128 * MV_PITCH, MT_BYTES = MK_BYTES + MV_BYTES;
static_assert(2 * MT_BYTES <= RING_BYTES && 4 * 64 * 66 * 4 <= RING_BYTES, "MLA LDS");
__device__ __forceinline__ void mla_prompt_unit(LAS unsigned char* lds, int b, int h, int qi, const bf16_t* QM, const bf16_t* KN, const bf16_t* VT, const bf16_t* krP, bf16_t* OML, int tid, int lane, int wave) {
    const int r = lane & 31, hi = lane >> 5, qsub = wave & 3, kgrp = wave >> 2;
    const int qrow = b * SEQ + qi * 128 + qsub * 32 + r, NT = 2 * qi + 2, ntw = (qsub < 2) ? NT - 1 : NT, krow0 = b * SEQ;
    const bf16_t* qp = QM + (size_t)qrow * 1536 + h * 192 + 8 * hi;
    bf16x8 qf[12];
#pragma unroll
    for (int ks = 0; ks < 12; ++ks) qf[ks] = *(const bf16x8*)(qp + 16 * ks);
    f32x16 o[4];
#pragma unroll
    for (int dt = 0; dt < 4; ++dt)
#pragma unroll
        for (int i = 0; i < 16; ++i) o[dt][i] = 0.f;
    float mrun = -1e30f, lsum = 0.f;
    const int kr0 = tid >> 4, kc0 = tid & 15, rr = tid >> 3, rc = tid & 7;
    const bf16_t* gk = KN + (size_t)(krow0 + kr0) * 1024 + h * 128 + kc0 * 8;
    const bf16_t* gr = krP + (size_t)(krow0 + rr) * 64 + 8 * rc;
    const bf16_t* gv = VT + (size_t)(h * 128 + rr) * VPITCH + krow0 + rc * 8;
    const int lk = kr0 * MK_PITCH + kc0 * 16, lr = rr * MK_PITCH + 256 + rc * 16, lv = MK_BYTES + rr * MV_PITCH + rc * 16;
    u32x4 ak0, ak1, av0, av1, bk0, bk1, bv0, bv1, ar1, br1;
#define MLA_ISSUE(P, t) do { P##k0 = *(const u32x4*)(gk + (size_t)(t) * 65536); P##k1 = *(const u32x4*)(gk + (size_t)(t) * 65536 + 32768); P##r1 = *(const u32x4*)(gr + (size_t)(t) * 4096); \
        P##v0 = *(const u32x4*)(gv + (t) * 64); P##v1 = *(const u32x4*)(gv + (t) * 64 + (size_t)64 * VPITCH); } while (0)
#define MLA_COMMIT(P, buf) do { LAS unsigned char* B_ = lds + (buf) * MT_BYTES; *(LAS u32x4*)(B_ + lk) = P##k0; *(LAS u32x4*)(B_ + lk + 32 * MK_PITCH) = P##k1; \
        *(LAS u32x4*)(B_ + lr) = P##r1; *(LAS u32x4*)(B_ + lv) = P##v0; *(LAS u32x4*)(B_ + lv + 64 * MV_PITCH) = P##v1; } while (0)
#define MLA_COMPUTE(t, buf) do { if ((t) < ntw) { const LAS unsigned char* Bt = lds + (buf) * MT_BYTES; f32x16 st; \
            _Pragma("unroll") for (int i = 0; i < 16; ++i) st[i] = 0.f; \
            _Pragma("unroll") for (int ks = 0; ks < 12; ++ks) st = MFMA32(*(const LAS bf16x8*)(Bt + ko + ks * 32), qf[ks], st); \
            bf16x8 pf0, pf1; mla_softmax_pv_prep(st, o, mrun, lsum, pf0, pf1); \
            _Pragma("unroll") for (int dt = 0; dt < 4; ++dt) { o[dt] = MFMA32(*(const LAS bf16x8*)(Bt + vo + dt * 32 * MV_PITCH), pf0, o[dt]); o[dt] = MFMA32(*(const LAS bf16x8*)(Bt + vo + dt * 32 * MV_PITCH + 32), pf1, o[dt]); } } } while (0)
    const int pr = pi32(r);
    const int ko = (32 * kgrp + pr) * MK_PITCH + hi * 16, vo = MK_BYTES + r * MV_PITCH + (32 * kgrp + 8 * hi) * 2;
    MLA_ISSUE(a, 0); MLA_ISSUE(b, 1); MLA_COMMIT(a, 0); __syncthreads();
    for (int t = 0; t < NT; t += 2) {
        if (t + 2 < NT) MLA_ISSUE(a, t + 2);
        MLA_COMPUTE(t, 0);
        MLA_COMMIT(b, 1);
        __syncthreads();
        if (t + 3 < NT) MLA_ISSUE(b, t + 3);
        MLA_COMPUTE(t + 1, 1);
        if (t + 2 < NT) MLA_COMMIT(a, 0);
        __syncthreads();
    }
#undef MLA_ISSUE
#undef MLA_COMMIT
#undef MLA_COMPUTE
    LAS float* X = (LAS float*)lds;
    if (kgrp == 1) { X[(0 * 4 + qsub) * 64 + lane] = mrun; X[(1 * 4 + qsub) * 64 + lane] = lsum;
#pragma unroll
        for (int dt = 0; dt < 4; ++dt)
#pragma unroll
            for (int i = 0; i < 16; ++i) X[((2 + dt * 16 + i) * 4 + qsub) * 64 + lane] = o[dt][i]; }
    __syncthreads();
    if (kgrp == 0) { const float m2 = X[(0 * 4 + qsub) * 64 + lane], l2 = X[(1 * 4 + qsub) * 64 + lane]; const float mnew = fmaxf(mrun, m2), a1 = __builtin_amdgcn_exp2f(mrun - mnew), a2 = __builtin_amdgcn_exp2f(m2 - mnew);
        lsum = lsum * a1 + l2 * a2;
#pragma unroll
        for (int dt = 0; dt < 4; ++dt)
#pragma unroll
            for (int i = 0; i < 16; ++i) o[dt][i] = o[dt][i] * a1 + X[((2 + dt * 16 + i) * 4 + qsub) * 64 + lane] * a2;
        lsum += __shfl_xor(lsum, 32);
        store_ot(OML + (size_t)qrow * 1024 + h * 128, o, 1.f / lsum, hi); }
    __syncthreads();
}
__device__ __forceinline__ void mla_sample_unit(LAS unsigned char* lds, int b, int h, const bf16_t* QM, const bf16_t* KN, const bf16_t* VT, const float* krC, const float* krN, bf16_t* OML, int lane, int wave) {
    const int r = lane & 31, hi = lane >> 5;
    const int qi = r < DEC_T ? r : DEC_T - 1, qrow = NPROMPT + b * DEC_T + qi, krow0 = NPROMPT + b * KEYS_S;
    const bf16_t* qp = QM + (size_t)qrow * 1536 + h * 192 + 8 * hi;
    bf16x8 qf[12];
#pragma unroll
    for (int ks = 0; ks < 12; ++ks) qf[ks] = *(const bf16x8*)(qp + 16 * ks);
    f32x16 o[4];
#pragma unroll
    for (int dt = 0; dt < 4; ++dt)
#pragma unroll
        for (int i = 0; i < 16; ++i) o[dt][i] = 0.f;
    float mrun = -1e30f, lsum = 0.f;
    const int pr = pi32(r);
    const bf16_t* vbase = VT + (size_t)(h * 128 + r) * VPITCH + krow0 + 8 * hi;
    for (int kt = wave; kt < PAST / 32 + 1; kt += NWAVES) {
        f32x16 st;
#pragma unroll
        for (int i = 0; i < 16; ++i) st[i] = 0.f;
        { const bf16_t* kp = KN + (size_t)(krow0 + kt * 32 + pr) * 1024 + h * 128 + 8 * hi;
#pragma unroll
          for (int ks = 0; ks < 8; ++ks) st = MFMA32(*(const bf16x8*)(kp + 16 * ks), qf[ks], st);
          const float* rp = (kt < PAST / 32) ? krC + ((size_t)b * PAST + kt * 32 + pr) * 64 : krN + (size_t)(b * DEC_T + (pr < DEC_T ? pr : DEC_T - 1)) * 64;
#pragma unroll
          for (int ks = 0; ks < 4; ++ks) { const f32x4 x1 = *(const f32x4*)(rp + 8 * ks + 4 * hi), x2 = *(const f32x4*)(rp + 32 + 8 * ks + 4 * hi);
              st = MFMA32(pack8f((f32x4){x1[0], x2[0], x1[1], x2[1]}, (f32x4){x1[2], x2[2], x1[3], x2[3]}), qf[8 + ks], st); } }
        if (kt == PAST / 32) {
#pragma unroll
            for (int i = 8; i < 16; ++i) st[i] = -INFINITY;
        }
        __builtin_amdgcn_sched_barrier(0);
        bf16x8 pf0, pf1; mla_softmax_pv_prep(st, o, mrun, lsum, pf0, pf1);
        __builtin_amdgcn_sched_barrier(0);
        const bf16_t* vp = vbase + kt * 32;
#pragma unroll
        for (int dt = 0; dt < 4; ++dt) { o[dt] = MFMA32(*(const bf16x8*)(vp + (size_t)dt * 32 * VPITCH), pf0, o[dt]); o[dt] = MFMA32(*(const bf16x8*)(vp + (size_t)dt * 32 * VPITCH + 16), pf1, o[dt]); }
    }
    LAS float* X = (LAS float*)lds;
    const int cl = hi * 16 + r;
    if (wave > 0 && r < DEC_T) { X[(0 * 7 + wave - 1) * 32 + cl] = mrun; X[(1 * 7 + wave - 1) * 32 + cl] = lsum;
#pragma unroll
        for (int dt = 0; dt < 4; ++dt)
#pragma unroll
            for (int i = 0; i < 16; ++i) X[((2 + dt * 16 + i) * 7 + wave - 1) * 32 + cl] = o[dt][i]; }
    __syncthreads();
    if (wave == 0) {
        if (r < DEC_T) {
#pragma unroll 1
            for (int w = 0; w < 7; ++w) { const float m2 = X[(0 * 7 + w) * 32 + cl], l2 = X[(1 * 7 + w) * 32 + cl]; const float mnew = fmaxf(mrun, m2), a1 = __builtin_amdgcn_exp2f(mrun - mnew), a2 = __builtin_amdgcn_exp2f(m2 - mnew);
                lsum = lsum * a1 + l2 * a2; mrun = mnew;
#pragma unroll
                for (int dt = 0; dt < 4; ++dt)
#pragma unroll
                    for (int i = 0; i < 16; ++i) o[dt][i] = o[dt][i] * a1 + X[((2 + dt * 16 + i) * 7 + w) * 32 + cl] * a2; }
        }
        lsum += __shfl_xor(lsum, 32);
        if (r < DEC_T) store_ot(OML + (size_t)qrow * 1024 + h * 128, o, 1.f / lsum, hi);
    }
    __syncthreads();
}

#ifndef MK_N_LAUNCHES
#define MK_N_LAUNCHES 1
#endif
constexpr int NPHASE = 15;
constexpr int N_LAUNCHES = MK_N_LAUNCHES;
static_assert(N_LAUNCHES == 1 || N_LAUNCHES == NPHASE, "MK_N_LAUNCHES is 1 or 15");
__device__ unsigned g_bar[XCD_BAR_WORDS + 64];
constexpr int GB_DONE = XCD_BAR_WORDS;
struct Args { const float* in[25]; float* out; unsigned char* ws; int ph_lo, ph_hi; };
static_assert(sizeof(Args) == 27 * 8 + 8, "Args has no padding");

__global__ void __launch_bounds__(NWAVES * 64, 2) fwd_kernel(Args args) {
    extern __shared__ __attribute__((aligned(16))) unsigned char lds_raw[];
    LAS unsigned char* lds = (LAS unsigned char*)lds_raw;
    volatile LAS unsigned* MISC = (volatile LAS unsigned*)(lds + MISC_OFF);
    const int tid = threadIdx.x, lane = tid & 63, wave = __builtin_amdgcn_readfirstlane(tid >> 6);
    const int G = gridDim.x, bx = blockIdx.x;
    const int gw = bx * NWAVES + wave, NGW = G * NWAVES;
    unsigned char* ws = args.ws; float* out = args.out;
    for (int u = tid; u < (LDS_BYTES - LDSCTL_OFF) / 4; u += NWAVES * 64) ((LAS unsigned*)(lds + LDSCTL_OFF))[u] = 0u;
    __syncthreads();
    XcdBarrier bar; bar.bar = g_bar; bar.x = 0; bar.st = nullptr;
    if (N_LAUNCHES == 1) bar = xcd_barrier_post(g_bar, MISC + 8);
    const int lo = args.ph_lo, hi = args.ph_hi;
#define IN(k) (lo <= (k) && (k) < hi)
#define SEAM(k) do { if (N_LAUNCHES == 1 && IN(k) && IN((k) + 1)) xcd_barrier(bar); } while (0)

    const float* x_p = args.in[0]; const float* x_s = args.in[1]; const float* cache_k = args.in[2]; const float* cache_v = args.in[3]; const float* cache_ckv = args.in[4]; const float* cache_kr = args.in[5];
    float* TAB = (float*)(ws + WS_TAB);
    bf16_t* W1I = (bf16_t*)(ws + WS_W1I); bf16_t* W1O = (bf16_t*)(ws + WS_W1O); bf16_t* WIN = (bf16_t*)(ws + WS_WIN); bf16_t* WUQ = (bf16_t*)(ws + WS_WUQ); bf16_t* WKV = (bf16_t*)(ws + WS_WKV);
    bf16_t* WBS = (bf16_t*)(ws + WS_WBS); bf16_t* WBM = (bf16_t*)(ws + WS_WBM); bf16_t* WO = (bf16_t*)(ws + WS_WO); bf16_t* W2I = (bf16_t*)(ws + WS_W2I); bf16_t* W2O = (bf16_t*)(ws + WS_W2O);
    bf16_t* HB = (bf16_t*)(ws + WS_HB); bf16_t* ACT = (bf16_t*)(ws + WS_ACT); bf16_t* Y = (bf16_t*)(ws + WS_Y); float* H = (float*)(ws + WS_H);
    bf16_t* QS = (bf16_t*)(ws + WS_QS); float* CQ = (float*)(ws + WS_CQ); float* CKV = (float*)(ws + WS_CKV); float* KR = (float*)(ws + WS_KR); bf16_t* Gt = (bf16_t*)(ws + WS_G);
    bf16_t* CKA = (bf16_t*)(ws + WS_CKA); bf16_t* CQB = (bf16_t*)(ws + WS_CQB); bf16_t* QM = (bf16_t*)(ws + WS_QM); bf16_t* KN = (bf16_t*)(ws + WS_KN); bf16_t* VT = (bf16_t*)(ws + WS_VT);
    float* SLAB = (float*)(ws + WS_CQ);
    bf16_t* KRB = (bf16_t*)(ws + WS_KRB);
    bf16_t* OSB = (bf16_t*)(ws + WS_OSB); bf16_t* OML = (bf16_t*)(ws + WS_OML); float* T = (float*)(ws + WS_T); bf16_t* MG = (bf16_t*)(ws + WS_MG);

    if (IN(0)) {
        LAS float* scr = (LAS float*)(lds + wave * 16384);
        transpose_matrix<1>(args.in[6], DM, 2 * FF, W1I, scr, gw, NGW, lane);
        { u32x4* z = (u32x4*)(WIN + (size_t)8256 * DM); const u32x4 zero = {0u, 0u, 0u, 0u};
          for (int i = bx * (NWAVES * 64) + tid; i < (NIN - 8256) * DM / 8; i += G * NWAVES * 64) z[i] = zero; }
        for (int m = gw; m < MTOK; m += NGW) { const float* xr = (m < NPROMPT ? x_p + (size_t)m * DM : x_s + (size_t)(m - NPROMPT) * DM) + lane * 8; bf16_t* xo = HB + (size_t)m * DM + lane * 8;
#pragma unroll
            for (int j = 0; j < 4; ++j) *(u32x4*)(xo + j * 512) = pk8(*(const f32x4*)(xr + j * 512), *(const f32x4*)(xr + j * 512 + 4)); }
        for (int i = bx * (NWAVES * 64) + tid; i < SEQ * 32; i += G * NWAVES * 64) { const int pos = i >> 5, fi = i & 31; const float inv = powf(10000.f, -(float)(2 * fi) / 64.f); const float ang = (float)pos * inv;
            TAB[2 * i] = cosf(ang); TAB[2 * i + 1] = sinf(ang); }
    }
    SEAM(0);
    if (IN(1)) { pg8::Gemm g{HB, W1I, MTOK, 2 * FF, DM}; pg8::StaticOrder S; S.init(MTOK, 2 * FF, G, bx, g.K); pg8::EpiSwiGLU E{ACT, FF};
        pg8::gemm_phase<pg8::EpiSwiGLU, pg8::StaticOrder, true, true>(lds, g, S, E);
        constexpr int R1 = (MTOK / 256) * (2 * FF / 256) % 256;
        if (G == 256 ? bx >= R1 : true) { const int fw = (G == 256 ? (bx - R1) : bx) * NWAVES + wave, FNW = (G == 256 ? (256 - R1) : G) * NWAVES; LAS float* scr = (LAS float*)(lds + wave * 16384);
            transpose_matrix<0>(args.in[7], FF, DM, W1O, scr, fw, FNW, lane);
            transpose_matrix<2>(args.in[10], DM, 8256, WIN, scr, fw, FNW, lane);
            transpose_matrix<3>(args.in[15], 512, 2048, WKV, scr, fw, FNW, lane);
        { const float* Wuq = args.in[13];
          for (int rho = fw; rho < 1536; rho += FNW) { const int hh = rho / 192, j = rho - hh * 192; const int src = j < 128 ? rho : hh * 192 + 128 + (((j - 128) & 1) ? 32 + ((j - 128) >> 1) : ((j - 128) >> 1));
              const float* wp = Wuq + src + (size_t)(lane * 8) * 1536; f32x4 a, c;
#pragma unroll
              for (int e = 0; e < 4; ++e) { a[e] = wp[(size_t)e * 1536]; c[e] = wp[(size_t)(4 + e) * 1536]; }
              *(u32x4*)(WUQ + (size_t)rho * 512 + lane * 8) = pk8(a, c); } }
        } }
    SEAM(1);
    if (IN(2)) { pg8::Gemm g{ACT, W1O, MTOK, DM, FF}; pg8::SplitOrder S; S.init(DM, G, bx, g.K); pg8::EpiResid E{x_p, x_s, Y, ALPHA, 0.5f, SLAB};
        pg8::gemm_phase<pg8::EpiResid, pg8::SplitOrder, true, true>(lds, g, S, E); }
    SEAM(2);
    if (IN(3)) ln_phase<pg8::split_nch(FF), false>(lds, Y, args.in[8], args.in[9], nullptr, nullptr, HB, SLAB, x_s, ALPHA, 0.5f, bx, G, tid, wave, lane);
    SEAM(3);
    if (IN(4)) { pg8::Gemm g{HB, WIN, MTOK, NIN, DM}; pg8::StaticOrder S; S.init(MTOK, NIN, G, bx, g.K);
        pg8::EpiWin E{QS, out, CQ, KR, Gt, args.in[11], SBQ_SCALE};
        pg8::gemm_phase<pg8::EpiWin, pg8::StaticOrder, true, true>(lds, g, S, E);
        constexpr int R4 = (MTOK / 256) * (NIN / 256) % 256;
        if (G == 256 ? bx >= R4 : true) { const int fw = (G == 256 ? (bx - R4) : bx) * NWAVES + wave, FNW = (G == 256 ? (256 - R4) : G) * NWAVES; LAS float* scr = (LAS float*)(lds + wave * 16384);
            transpose_matrix<0>(args.in[16], 1024, DM, WBS, scr, fw, FNW, lane);
            transpose_matrix<0>(args.in[17], 1024, DM, WBM, scr, fw, FNW, lane);
            transpose_matrix<0>(args.in[18], DM, DM, WO, scr, fw, FNW, lane);
            transpose_matrix<1>(args.in[21], DM, 2 * FF, W2I, scr, fw, FNW, lane);
            transpose_matrix<0>(args.in[22], FF, DM, W2O, scr, fw, FNW, lane);
        } }
    SEAM(4);
    if (IN(5)) {
        const float* gcq = args.in[12]; const float* gckv = args.in[14];
        for (int m = gw; m < MTOK; m += NGW) {
            { const float* p = CQ + (size_t)m * 512 + lane * 8; const f32x4 a = *(const f32x4*)p, c = *(const f32x4*)(p + 4);
              const float ss = wave_sum((a[0] * a[0] + a[1] * a[1]) + (a[2] * a[2] + a[3] * a[3]) + (c[0] * c[0] + c[1] * c[1]) + (c[2] * c[2] + c[3] * c[3]));
              const float rs = 1.f / sqrtf(ss * (1.f / 512.f) + RMS_EPS); const f32x4 g0 = *(const f32x4*)(gcq + lane * 8), g1 = *(const f32x4*)(gcq + lane * 8 + 4);
              *(u32x4*)(CQB + (size_t)m * 512 + lane * 8) = pk8(a * rs * g0, c * rs * g1); }
            { const float* p = CKV + (size_t)m * 512 + lane * 8; const f32x4 a = *(const f32x4*)p, c = *(const f32x4*)(p + 4);
              const float ss = wave_sum((a[0] * a[0] + a[1] * a[1]) + (a[2] * a[2] + a[3] * a[3]) + (c[0] * c[0] + c[1] * c[1]) + (c[2] * c[2] + c[3] * c[3]));
              const float rs = 1.f / sqrtf(ss * (1.f / 512.f) + RMS_EPS); const f32x4 g0 = *(const f32x4*)(gckv + lane * 8), g1 = *(const f32x4*)(gckv + lane * 8 + 4);
              const f32x4 y0 = a * rs * g0, y1 = c * rs * g1;
              float* po = (m < NPROMPT ? out + O_CKVP + (size_t)m * 512 : out + O_CKVS + (size_t)(m - NPROMPT) * 512) + lane * 8; *(f32x4*)po = y0; *(f32x4*)(po + 4) = y1;
              *(u32x4*)(CKA + (size_t)tok_krow(m) * 512 + lane * 8) = pk8(y0, y1); }
            if (lane < 32) { const float x1 = KR[(size_t)m * 64 + lane], x2 = KR[(size_t)m * 64 + 32 + lane]; const int pos = tok_pos(m); const float cs = TAB[(size_t)pos * 64 + 2 * lane], sn = TAB[(size_t)pos * 64 + 2 * lane + 1];
              float* po = (m < NPROMPT ? out + O_KRP + (size_t)m * 64 : out + O_KRS + (size_t)(m - NPROMPT) * 64); const float o1 = x1 * cs - x2 * sn, o2 = x2 * cs + x1 * sn; po[lane] = o1; po[32 + lane] = o2; if (m < NPROMPT) ((unsigned*)KRB)[(size_t)m * 32 + lane] = pk2(o1, o2); }
        }
        for (int rr = gw; rr < DEC_B * PAST; rr += NGW) { const int b = rr >> 10, key = rr & (PAST - 1); const float* p = cache_ckv + (size_t)rr * 512 + lane * 8;
            *(u32x4*)(CKA + (size_t)(NPROMPT + b * KEYS_S + key) * 512 + lane * 8) = pk8(*(const f32x4*)p, *(const f32x4*)(p + 4)); }
        for (int i = bx * (NWAVES * 64) + tid; i < 1024 * 8; i += G * NWAVES * 64) { const u32x4 zero = {0u, 0u, 0u, 0u}; *(u32x4*)(VT + (size_t)(i >> 3) * VPITCH + KROWS + (i & 7) * 8) = zero; }
    }
    SEAM(5);
    if (IN(6)) {
        { pg8::Gemm g{CQB, WUQ, MTOK, 1536, 512, (long)WS_CKA - (long)WS_CQB, (long)WS_WKV - (long)WS_WUQ, (long)(WS_WKV + (size_t)1024 * 512 * 2) - (long)WS_CQB, (long)WS_CKA - (long)WS_WUQ};
          pg8::Order3 S; S.init(MTOK, 1536, KROWS, 1024, 1024, KROWS, G, bx, g.K);
          pg8::EpiP6 E{pg8::EpiUq{QM, TAB, MLAQ_SCALE}, pg8::EpiPlain{KN, 1024}, pg8::EpiPlain{VT, VPITCH}};
          pg8::gemm_phase<pg8::EpiP6, pg8::Order3, true, true>(lds, g, S, E); }
        for (int u = bx; u < 2 * 8 * (SEQ / 256); u += G) sb_prompt_unit(lds, u >> 7, (u >> 4) & 7, u & 15, QS, out + O_KP, out + O_VP, OSB, tid, lane, wave);
        for (int u = (G == 256 ? bx - 128 : bx); u >= 0 && u < DEC_B * 8; u += G) sb_sample_unit(lds, u >> 3, u & 7, QS, cache_k, cache_v, out + O_KS, out + O_VS, OSB, lane, wave);
    }
    SEAM(6);
    if (IN(7)) {
        { const int bh = (bx >> 4) & 15, j = bx & 15;
          for (int c0 = bx; c0 < 256; c0 += G) { const int c = (G == 256) ? ((c0 & 7) * 32 + (c0 >> 3)) : c0;
              const int bh2 = c >> 4, j2 = c & 15;
              mla_prompt_unit(lds, bh2 >> 3, bh2 & 7, 31 - j2, QM, KN, VT, KRB, OML, tid, lane, wave);
              mla_prompt_unit(lds, bh2 >> 3, bh2 & 7, j2, QM, KN, VT, KRB, OML, tid, lane, wave); }
          (void)bh; (void)j; }
        for (int u = bx; u < DEC_B * 8; u += G) mla_sample_unit(lds, u >> 3, u & 7, QM, KN, VT, cache_kr, out + O_KRS, OML, lane, wave);
    }
    SEAM(7);
    if (IN(8)) {
        float* SL8 = (float*)(ws + WS_KN);
        { pg8::Gemm g{OSB, WBS, MTOK, DM, 1024}; pg8::SplitOrder S; S.init(DM, G, bx, g.K, 0); pg8::EpiBrSb E{T, Gt, SL8};
          pg8::gemm_phase<pg8::EpiBrSb, pg8::SplitOrder, true, true>(lds, g, S, E); }
        { pg8::Gemm g{OML, WBM, MTOK, DM, 1024}; pg8::SplitOrder S; S.init(DM, G, bx, g.K, 64); pg8::EpiBrMla E{T, Gt, MG, SL8 + (size_t)8 * NSAMPLE * DM};
          pg8::gemm_phase<pg8::EpiBrMla, pg8::SplitOrder, true, true>(lds, g, S, E); }
    }
    SEAM(8);
    if (IN(9)) {
        const f32x4* SL8 = (const f32x4*)(ws + WS_KN);
        for (int sr = bx; sr < NSAMPLE; sr += G) {
            const f32x4* sp = SL8 + (size_t)sr * (DM / 4) + tid; f32x4 a = sp[0], c = sp[(size_t)8 * (NSAMPLE * DM / 4)];
#pragma unroll
            for (int k = 1; k < 8; ++k) { a += sp[(size_t)k * (NSAMPLE * DM / 4)]; c += sp[(size_t)(8 + k) * (NSAMPLE * DM / 4)]; }
            const bf16_t* gp = Gt + (size_t)(NPROMPT + sr) * 4096 + tid * 4; const u32x2 gs = *(const u32x2*)gp, gm = *(const u32x2*)(gp + 2048);
            const f32x4 g0 = {pg8::bf_lo(gs.x), pg8::bf_hi(gs.x), pg8::bf_lo(gs.y), pg8::bf_hi(gs.y)}, g1 = {pg8::bf_lo(gm.x), pg8::bf_hi(gm.x), pg8::bf_lo(gm.y), pg8::bf_hi(gm.y)};
            const f32x4 o = g0 * a + g1 * c; u32x2 w; w.x = pk2(o[0], o[1]); w.y = pk2(o[2], o[3]);
            *(u32x2*)(MG + (size_t)(NPROMPT + sr) * DM + tid * 4) = w; }
    }
    SEAM(9);
    if (IN(10)) { pg8::Gemm g{MG, WO, MTOK, DM, DM}; pg8::SplitOrder S; S.init(DM, G, bx, g.K); pg8::EpiResidB E{HB, Y, ALPHA, 1.f, SLAB};
        pg8::gemm_phase<pg8::EpiResidB, pg8::SplitOrder, true, true>(lds, g, S, E); }
    SEAM(10);
    if (IN(11)) ln_phase<pg8::split_nch(DM), true>(lds, Y, args.in[19], args.in[20], nullptr, nullptr, HB, SLAB, HB + (size_t)NPROMPT * DM, ALPHA, 1.f, bx, G, tid, wave, lane);
    SEAM(11);
    if (IN(12)) { pg8::Gemm g{HB, W2I, MTOK, 2 * FF, DM}; pg8::StaticOrder S; S.init(MTOK, 2 * FF, G, bx, g.K); pg8::EpiSwiGLU E{ACT, FF};
        pg8::gemm_phase<pg8::EpiSwiGLU, pg8::StaticOrder, true, true>(lds, g, S, E); }
    SEAM(12);
    if (IN(13)) { pg8::Gemm g{ACT, W2O, MTOK, DM, FF}; pg8::SplitOrder S; S.init(DM, G, bx, g.K); pg8::EpiResidB E{HB, Y, ALPHA, 0.5f, SLAB};
        pg8::gemm_phase<pg8::EpiResidB, pg8::SplitOrder, true, true>(lds, g, S, E); }
    SEAM(13);
    if (IN(14)) ln_phase<pg8::split_nch(FF), true>(lds, Y, args.in[23], args.in[24], out + O_YP, out + O_YS, nullptr, SLAB, HB + (size_t)NPROMPT * DM, ALPHA, 0.5f, bx, G, tid, wave, lane);
#undef IN
#undef SEAM
    if (N_LAUNCHES == 1) {
        __syncthreads();
        if (tid == 0) MISC[12] = (xb_add(&g_bar[GB_DONE], 1u) == (unsigned)G - 1u) ? 1u : 0u;
        __syncthreads();
        if (MISC[12]) { for (int i = tid; i < XCD_BAR_WORDS + 64; i += NWAVES * 64) __hip_atomic_store(&g_bar[i], 0u, __ATOMIC_RELAXED, __HIP_MEMORY_SCOPE_AGENT); }
    }
}

extern "C" void kernel_launch(void* const* d_in, const int* in_sizes, int n_in, void* d_out, int out_size, void* d_ws, size_t ws_size, hipStream_t stream) {
    static int grid = 0;
    if (grid == 0) {
        if (n_in != 25 || out_size != (int)O_END || ws_size < WS_END) { fprintf(stderr, "kernel_launch: expected 25 inputs, %zu outputs, >= %zu B workspace; got %d, %d, %zu\n", (size_t)O_END, (size_t)WS_END, n_in, out_size, ws_size); grid = -1; return; }
        int dev = 0, cus = 0, per_cu = 0;
        if (hipGetDevice(&dev) != hipSuccess || hipDeviceGetAttribute(&cus, hipDeviceAttributeMultiprocessorCount, dev) != hipSuccess) { grid = -1; return; }
        if (hipFuncSetAttribute((const void*)fwd_kernel, hipFuncAttributeMaxDynamicSharedMemorySize, LDS_BYTES) != hipSuccess) { fprintf(stderr, "kernel_launch: hipFuncSetAttribute failed\n"); grid = -1; return; }
        if (hipOccupancyMaxActiveBlocksPerMultiprocessor(&per_cu, (const void*)fwd_kernel, NWAVES * 64, LDS_BYTES) != hipSuccess || per_cu < 1) fprintf(stderr, "kernel_launch: occupancy query says %d\n", per_cu);
        (void)hipGetLastError();
        grid = cus;
        if (grid != 256) { fprintf(stderr, "kernel_launch: built for a 256-CU device (the split-K order deals exactly 256 prompt tiles), found %d CUs; nothing launched\n", cus); grid = -1; return; }
    }
    if (grid < 0) return;
    Args a{};
    for (int i = 0; i < 25; ++i) a.in[i] = (const float*)d_in[i];
    a.out = (float*)d_out; a.ws = (unsigned char*)d_ws;
    for (int li = 0; li < N_LAUNCHES; ++li) {
        a.ph_lo = (N_LAUNCHES == 1) ? 0 : li; a.ph_hi = (N_LAUNCHES == 1) ? NPHASE : li + 1;
        hipLaunchKernelGGL(fwd_kernel, dim3(grid), dim3(NWAVES * 64), LDS_BYTES, stream, a);
        const hipError_t le = hipPeekAtLastError();
        if (le != hipSuccess) { fprintf(stderr, "kernel_launch: launch %d failed: %s\n", li, hipGetErrorName(le)); break; }
    }
}
```

```cpp
#include <hip/hip_runtime.h>
#include <cstdio>
#include <cstdint>
#include <cmath>
constexpr int DM = 2048, NPROMPT = 8192, NSAMPLE = 256, MTOK = NPROMPT + NSAMPLE;
constexpr int SEQ = 4096, DEC_B = 16, DEC_T = 16, PAST = 1024, KEYS_S = PAST + DEC_T;
constexpr int FF = 5504, NIN = 8448;
constexpr int KROWS = NPROMPT + DEC_B * KEYS_S;
constexpr int VPITCH = KROWS + 64;
constexpr float LN_EPS = 1e-5f, RMS_EPS = 1e-6f;
constexpr float ALPHA = 1.18920711500272f;
constexpr float LOG2E = 1.4426950408889634f;
constexpr float SBQ_SCALE = 0.08838834764831845f * LOG2E;
constexpr float MLAQ_SCALE = 0.07216878364870323f * LOG2E;
namespace pg8 {
#define PG8_LAS __attribute__((address_space(3)))
typedef unsigned short bf16_t;
typedef short bf16x8 __attribute__((ext_vector_type(8)));
typedef float f32x4 __attribute__((ext_vector_type(4)));
typedef unsigned u32x4 __attribute__((ext_vector_type(4)));
constexpr int BM = 256, BK = 64, HALF = 128, HTB = HALF * BK * 2  , STAGE_BYTES = 8 * HTB, NXCD = 8, WGM = 8;

__host__ __device__ __forceinline__ int lds_byte(int r, int c) { const int st = (r >> 4) * 2 + (c >> 5), rr = r & 15, cc = c & 31, ob = rr * 64 + cc * 2; return st * 1024 + (ob ^ (((ob >> 9) & 1) << 5)); }
__host__ __device__ __forceinline__ void stage_rc(int b, int& R, int& C) { const int st = b / 1024, sb = b % 1024, swz = sb ^ (((sb >> 9) & 1) << 5); R = (st >> 1) * 16 + swz / 64; C = (st & 1) * 32 + (swz % 64) / 2; }
__host__ __device__ __forceinline__ int perm32(int rho) { const int n = rho >> 4, i = rho & 15; return 8 * (i >> 2) + 4 * n + (i & 3); }

struct Unit { int pm, pn, kofs, nt, chunk; };
struct Gemm { const bf16_t* A; const bf16_t* Bt; int M, N, K; };

struct StaticOrder {
    int nM, nN, nwg, G, c, ntf;
    __host__ __device__ void init(int M, int N, int G_, int c_, int K_) { nM = M / BM; nN = N / BM; nwg = nM * nN; G = G_; c = c_; ntf = K_ / BK; }
    __host__ __device__ bool next(int i, Unit& u) const {
        const long L = (long)i * G + c; if (L >= nwg) return false;
        int wgid = (int)L; { const int q = nwg / NXCD, r = nwg % NXCD, xcd = wgid % NXCD, off = wgid / NXCD; wgid = (xcd < r ? xcd * (q + 1) : r * (q + 1) + (xcd - r) * q) + off; }
        const int nig = WGM * nN, gid = wgid / nig, fm = gid * WGM, gsz = (nM - fm) < WGM ? (nM - fm) : WGM;
        u.pm = fm + ((wgid % nig) % gsz); u.pn = (wgid % nig) / gsz; u.kofs = 0; u.nt = ntf; u.chunk = -1; return true;
    }
    __device__ __forceinline__ void a_ready(const Unit&) const {}
    __device__ __forceinline__ void done(const Unit&) const {}
};

struct SplitOrder {
    StaticOrder P; int nch, base, extra, c;
    __host__ __device__ void init(int N, int G_, int c_, int K_, int coff = 0) { P.init(NPROMPT, N, G_, c_, K_); const int np = K_ / (2 * BK); nch = np < 32 ? np : 32; base = np / nch; extra = np % nch; c = c_ - coff; }
    __host__ __device__ bool next(int i, Unit& u) const {
        if (i == 0) return P.next(0, u);
        if (i > 1 || c < 0 || c >= 8 * nch) return false;
        const int j = c >> 3; u.pm = NPROMPT / BM; u.pn = c & 7; u.chunk = j; u.nt = 2 * (base + (j < extra ? 1 : 0)); u.kofs = 2 * BK * (j * base + (j < extra ? j : extra)); return true;
    }
    __device__ __forceinline__ void a_ready(const Unit&) const {}
    __device__ __forceinline__ void done(const Unit&) const {}
};
constexpr int split_nch(int K_) { return (K_ / 128) < 32 ? (K_ / 128) : 32; }

__device__ __forceinline__ unsigned cvt_pk_bf16(float lo, float hi) { unsigned r; asm volatile("v_cvt_pk_bf16_f32 %0, %1, %2" : "=v"(r) : "v"(lo), "v"(hi)); return r; }
typedef float f32x2 __attribute__((ext_vector_type(2)));
typedef float f32x2_t __attribute__((ext_vector_type(2))); typedef __bf16 bf16x2_t __attribute__((ext_vector_type(2)));
__device__ __forceinline__ unsigned pk2(float lo, float hi) { f32x2_t v = {lo, hi}; bf16x2_t b = __builtin_convertvector(v, bf16x2_t); return __builtin_bit_cast(unsigned, b); }
__device__ __forceinline__ u32x4 pk8(const f32x4 a, const f32x4 b) { u32x4 w; w.x = pk2(a[0], a[1]); w.y = pk2(a[2], a[3]); w.z = pk2(b[0], b[1]); w.w = pk2(b[2], b[3]); return w; }
__device__ __forceinline__ float bf_lo(unsigned w) { return __builtin_bit_cast(float, w << 16); }
__device__ __forceinline__ float bf_hi(unsigned w) { return __builtin_bit_cast(float, w & 0xffff0000u); }
__device__ __forceinline__ void unpk8(const u32x4 w, f32x4& a, f32x4& b) { a = (f32x4){bf_lo(w.x), bf_hi(w.x), bf_lo(w.y), bf_hi(w.y)}; b = (f32x4){bf_lo(w.z), bf_hi(w.z), bf_lo(w.w), bf_hi(w.w)}; }
__device__ __forceinline__ float silu_f(float x) { return x * __builtin_amdgcn_rcpf(1.f + __builtin_amdgcn_exp2f(-1.4426950408889634f * x)); }
__device__ __forceinline__ float sigmoid_f(float x) { return __builtin_amdgcn_rcpf(1.f + __builtin_amdgcn_exp2f(-1.4426950408889634f * x)); }

#define EPI_LOOP_AM _Pragma("unroll") for (int ai = 0; ai < 2; ++ai) _Pragma("unroll") for (int m = 0; m < 4; ++m)

struct EpiSwiGLU {
    static constexpr bool PERM = true, AFTER_DRAIN = false;
    bf16_t* O; int ldc;
    __device__ __forceinline__ void operator()(const f32x4 (&acc)[2][2][4][2], const Unit& u, int wr, int wc, int fr, int fq) const {
        const int row0 = u.pm * BM + wr * 64 + fr, col0 = u.pn * 128 + wc * 32 + 8 * fq;
        EPI_LOOP_AM { bf16_t* p = O + (size_t)(row0 + ai * HALF + m * 16) * ldc + col0;
            f32x4 a, b;
#pragma unroll
            for (int e = 0; e < 4; ++e) { a[e] = silu_f(acc[ai][0][m][0][e]) * acc[ai][1][m][0][e]; b[e] = silu_f(acc[ai][0][m][1][e]) * acc[ai][1][m][1][e]; }
            *(u32x4*)p = pk8(a, b); }
    }
};
struct EpiPlain {
    static constexpr bool PERM = true, AFTER_DRAIN = false;
    bf16_t* O; int ldc;
    __device__ __forceinline__ void operator()(const f32x4 (&acc)[2][2][4][2], const Unit& u, int wr, int wc, int fr, int fq) const {
        const int row0 = u.pm * BM + wr * 64 + fr, col0 = u.pn * BM + wc * 32 + 8 * fq;
        EPI_LOOP_AM { bf16_t* p = O + (size_t)(row0 + ai * HALF + m * 16) * ldc + col0;
#pragma unroll
            for (int bj = 0; bj < 2; ++bj) *(u32x4*)(p + bj * HALF) = pk8(acc[ai][bj][m][0], acc[ai][bj][m][1]); }
    }
};
struct EpiResid {
    static constexpr bool PERM = true, AFTER_DRAIN = false;
    const float* R0; const float* R1; bf16_t* Y; float alpha, s; float* slab;
    __device__ __forceinline__ void operator()(const f32x4 (&acc)[2][2][4][2], const Unit& u, int wr, int wc, int fr, int fq) const {
        const int row0 = u.pm * BM + wr * 64 + fr, col0 = u.pn * BM + wc * 32 + 8 * fq;
        const bool part = u.chunk >= 0;
        const float al = part ? 0.f : alpha, sc = part ? 1.f : s;
        const float* Rb = (u.pm < NPROMPT / BM) ? R0 + (size_t)row0 * DM : R1 + (size_t)(row0 - NPROMPT) * DM;
        float* Sb = slab + ((size_t)(part ? u.chunk : 0) * NSAMPLE + (part ? row0 - NPROMPT : 0)) * DM;
        EPI_LOOP_AM { const size_t ro = (size_t)(ai * HALF + m * 16) * DM + col0; const float* rp = Rb + ro;
#pragma unroll
            for (int bj = 0; bj < 2; ++bj) { const f32x4 r0 = *(const f32x4*)(rp + bj * HALF), r1 = *(const f32x4*)(rp + bj * HALF + 4);
                const f32x4 y0 = r0 * al + acc[ai][bj][m][0] * sc, y1 = r1 * al + acc[ai][bj][m][1] * sc;
                if (part) { *(f32x4*)(Sb + ro + bj * HALF) = y0; *(f32x4*)(Sb + ro + bj * HALF + 4) = y1; }
                else *(u32x4*)(Y + (size_t)row0 * DM + ro + bj * HALF) = pk8(y0, y1); } }
    }
};
struct EpiResidB {
    static constexpr bool PERM = true, AFTER_DRAIN = false;
    const bf16_t* RB; bf16_t* Y; float alpha, s; float* slab;
    __device__ __forceinline__ void operator()(const f32x4 (&acc)[2][2][4][2], const Unit& u, int wr, int wc, int fr, int fq) const {
        const int row0 = u.pm * BM + wr * 64 + fr, col0 = u.pn * BM + wc * 32 + 8 * fq;
        const bool part = u.chunk >= 0;
        const float al = part ? 0.f : alpha, sc = part ? 1.f : s;
        const bf16_t* Rb = RB + (size_t)row0 * DM;
        float* Sb = slab + ((size_t)(part ? u.chunk : 0) * NSAMPLE + (part ? row0 - NPROMPT : 0)) * DM;
        EPI_LOOP_AM { const size_t ro = (size_t)(ai * HALF + m * 16) * DM + col0; const bf16_t* rp = Rb + ro;
#pragma unroll
            for (int bj = 0; bj < 2; ++bj) { f32x4 r0, r1; unpk8(*(const u32x4*)(rp + bj * HALF), r0, r1);
                const f32x4 y0 = r0 * al + acc[ai][bj][m][0] * sc, y1 = r1 * al + acc[ai][bj][m][1] * sc;
                if (part) { *(f32x4*)(Sb + ro + bj * HALF) = y0; *(f32x4*)(Sb + ro + bj * HALF + 4) = y1; }
                else *(u32x4*)(Y + (size_t)row0 * DM + ro + bj * HALF) = pk8(y0, y1); } }
    }
};
struct EpiWin {
    static constexpr bool PERM = true, AFTER_DRAIN = false;
    bf16_t* QS; float* out; float* CQ; float* KR; bf16_t* G; const float* bgate; float qscale;
    __device__ __forceinline__ void operator()(const f32x4 (&acc)[2][2][4][2], const Unit& u, int wr, int wc, int fr, int fq) const {
        const int row0 = u.pm * BM + wr * 64 + fr, colt = wc * 32 + 8 * fq; const int pn = u.pn;
        if (pn < 4) {
            EPI_LOOP_AM { bf16_t* p = QS + (size_t)(row0 + ai * HALF + m * 16) * 1024 + pn * BM + colt;
#pragma unroll
                for (int bj = 0; bj < 2; ++bj) *(u32x4*)(p + bj * HALF) = pk8(acc[ai][bj][m][0] * qscale, acc[ai][bj][m][1] * qscale); }
        } else if (pn < 12) {
            const bool isk = pn < 8; const bool smp = u.pm >= NPROMPT / BM;
            size_t off = isk ? (size_t)17301504 : (size_t)25690112;
            if (smp) off = isk ? (size_t)38797312 : (size_t)39059456;
            const int rr = smp ? row0 - NPROMPT : row0; const int cc = (pn - (isk ? 4 : 8)) * BM + colt;
            EPI_LOOP_AM { float* p = out + off + (size_t)(rr + ai * HALF + m * 16) * 1024 + cc;
#pragma unroll
                for (int bj = 0; bj < 2; ++bj) { *(f32x4*)(p + bj * HALF) = acc[ai][bj][m][0]; *(f32x4*)(p + bj * HALF + 4) = acc[ai][bj][m][1]; } }
        } else if (pn < 16) {
            const size_t off = (pn < 14 ? (size_t)0 : (size_t)MTOK * 512); const int cc = (pn & 1) * BM + colt;
            EPI_LOOP_AM { float* p = CQ + off + (size_t)(row0 + ai * HALF + m * 16) * 512 + cc;
#pragma unroll
                for (int bj = 0; bj < 2; ++bj) { *(f32x4*)(p + bj * HALF) = acc[ai][bj][m][0]; *(f32x4*)(p + bj * HALF + 4) = acc[ai][bj][m][1]; } }
        } else if (pn < 32) {
            const int cc = (pn - 16) * BM + colt;
            f32x4 bg[2][2];
#pragma unroll
            for (int bj = 0; bj < 2; ++bj) { bg[bj][0] = *(const f32x4*)(bgate + cc + bj * HALF); bg[bj][1] = *(const f32x4*)(bgate + cc + bj * HALF + 4); }
            EPI_LOOP_AM { bf16_t* p = G + (size_t)(row0 + ai * HALF + m * 16) * 4096 + cc;
#pragma unroll
                for (int bj = 0; bj < 2; ++bj) { f32x4 a = acc[ai][bj][m][0] + bg[bj][0], b = acc[ai][bj][m][1] + bg[bj][1];
#pragma unroll
                    for (int e = 0; e < 4; ++e) { a[e] = sigmoid_f(a[e]); b[e] = sigmoid_f(b[e]); }
                    *(u32x4*)(p + bj * HALF) = pk8(a, b); } }
        } else {
            if (wc < 2) { EPI_LOOP_AM { float* p = KR + (size_t)(row0 + ai * HALF + m * 16) * 64 + colt; *(f32x4*)p = acc[ai][0][m][0]; *(f32x4*)(p + 4) = acc[ai][0][m][1]; } }
        }
    }
};
struct EpiUq {
    static constexpr bool PERM = true, AFTER_DRAIN = false;
    bf16_t* QM; const float* tab; float scale;
    __device__ __forceinline__ void operator()(const f32x4 (&acc)[2][2][4][2], const Unit& u, int wr, int wc, int fr, int fq) const {
        const int row0 = u.pm * BM + wr * 64 + fr, col0 = u.pn * BM + wc * 32 + 8 * fq;
        EPI_LOOP_AM { const int row = row0 + ai * HALF + m * 16; const int pos = row < NPROMPT ? (row & 4095) : 1024 + ((row - NPROMPT) & 15);
            bf16_t* p = QM + (size_t)row * 1536 + col0;
#pragma unroll
            for (int bj = 0; bj < 2; ++bj) { const int col = col0 + bj * HALF; const int hc = col % 192; f32x4 a = acc[ai][bj][m][0], b = acc[ai][bj][m][1];
                if (hc >= 128) { const float* t = tab + (size_t)pos * 64 + (hc - 128);
                    const f32x4 t0 = *(const f32x4*)t, t1 = *(const f32x4*)(t + 4);
                    const f32x4 a2 = {a[0] * t0[0] - a[1] * t0[1], a[1] * t0[0] + a[0] * t0[1], a[2] * t0[2] - a[3] * t0[3], a[3] * t0[2] + a[2] * t0[3]};
                    const f32x4 b2 = {b[0] * t1[0] - b[1] * t1[1], b[1] * t1[0] + b[0] * t1[1], b[2] * t1[2] - b[3] * t1[3], b[3] * t1[2] + b[2] * t1[3]};
                    a = a2; b = b2; }
                *(u32x4*)(p + bj * HALF) = pk8(a * scale, b * scale); } }
    }
};
struct EpiBrSb {
    static constexpr bool PERM = true, AFTER_DRAIN = false;
    float* T; const bf16_t* G; float* slab;
    __device__ __forceinline__ void operator()(const f32x4 (&acc)[2][2][4][2], const Unit& u, int wr, int wc, int fr, int fq) const {
        const int row0 = u.pm * BM + wr * 64 + fr, col0 = u.pn * BM + wc * 32 + 8 * fq; const bool part = u.chunk >= 0;
        float* Tb = part ? slab + ((size_t)u.chunk * NSAMPLE + (row0 - NPROMPT)) * DM : T + (size_t)row0 * DM;
        EPI_LOOP_AM { const int ro = ai * HALF + m * 16; const bf16_t* gp = G + (size_t)(row0 + ro) * 4096 + col0; float* tp = Tb + (size_t)ro * DM + col0;
#pragma unroll
            for (int bj = 0; bj < 2; ++bj) { f32x4 g0, g1; unpk8(*(const u32x4*)(gp + bj * HALF), g0, g1); if (part) { g0 = (f32x4){1.f, 1.f, 1.f, 1.f}; g1 = g0; }
                *(f32x4*)(tp + bj * HALF) = g0 * acc[ai][bj][m][0]; *(f32x4*)(tp + bj * HALF + 4) = g1 * acc[ai][bj][m][1]; } }
    }
};
struct EpiBrMla {
    static constexpr bool PERM = true, AFTER_DRAIN = false;
    const float* T; const bf16_t* G; bf16_t* MG; float* slab;
    __device__ __forceinline__ void operator()(const f32x4 (&acc)[2][2][4][2], const Unit& u, int wr, int wc, int fr, int fq) const {
        const int row0 = u.pm * BM + wr * 64 + fr, col0 = u.pn * BM + wc * 32 + 8 * fq;
        if (u.chunk >= 0) { float* sp = slab + ((size_t)u.chunk * NSAMPLE + (row0 - NPROMPT)) * DM + col0;
            EPI_LOOP_AM { float* tp = sp + (size_t)(ai * HALF + m * 16) * DM;
#pragma unroll
                for (int bj = 0; bj < 2; ++bj) { *(f32x4*)(tp + bj * HALF) = acc[ai][bj][m][0]; *(f32x4*)(tp + bj * HALF + 4) = acc[ai][bj][m][1]; } }
        } else
        EPI_LOOP_AM { const int row = row0 + ai * HALF + m * 16; const bf16_t* gp = G + (size_t)row * 4096 + 2048 + col0; const float* tp = T + (size_t)row * DM + col0; bf16_t* op = MG + (size_t)row * DM + col0;
#pragma unroll
            for (int bj = 0; bj < 2; ++bj) { f32x4 g0, g1; unpk8(*(const u32x4*)(gp + bj * HALF), g0, g1);
                const f32x4 t0 = *(const f32x4*)(tp + bj * HALF), t1 = *(const f32x4*)(tp + bj * HALF + 4);
                *(u32x4*)(op + bj * HALF) = pk8(t0 + g0 * acc[ai][bj][m][0], t1 + g1 * acc[ai][bj][m][1]); } }
    }
};
template <class Epi, class Sched, bool ALIGN_EPI = false, bool SP2 = false>
__device__ __forceinline__ void gemm_phase(PG8_LAS unsigned char* lds, const Gemm g, const Sched& S, const Epi& E) {
    const int tid = threadIdx.x, wid = __builtin_amdgcn_readfirstlane(tid >> 6), lane = tid & 63, wr = wid >> 2, wc = wid & 3, fr = lane & 15, fq = lane >> 4;
    const int K = g.K;
    unsigned voffA[2], voffB[2];
#pragma unroll
    for (int i = 0; i < 2; ++i) { int R, C; stage_rc(tid * 16 + i * 8192, R, C); const int Rb = Epi::PERM ? ((R & ~31) + perm32(R & 31)) : R;
        voffA[i] = (unsigned)(R * K + C) * 2u; voffB[i] = (unsigned)(Rb * K + C) * 2u; }
    const size_t kstep = (size_t)(BK * 2);
    const size_t hstep = (size_t)HALF * K * 2;
    const size_t tstep = 2 * hstep;
    const unsigned ldsw = (unsigned)wid * 1024u;
    const int aoff = lds_byte(wr * 64 + fr, fq * 8), boff = lds_byte(wc * 32 + fr, fq * 8);
#define PG8_SA(b, h) (((b) * 2 + (h)) * HTB)
#define PG8_SB(b, h) ((4 + (b) * 2 + (h)) * HTB)
#define PG8_STAGE(bufoff, gbase, voff) do { _Pragma("unroll") for (int _i = 0; _i < 2; ++_i) \
        __builtin_amdgcn_global_load_lds((const unsigned*)((const char*)(gbase) + (voff)[_i]), (PG8_LAS unsigned*)(lds + (bufoff) + ldsw + _i * 8192), 16, 0, 0); } while (0)
#define PG8_LDA(dst, b, h) do { _Pragma("unroll") for (int m = 0; m < 4; ++m) _Pragma("unroll") for (int k = 0; k < 2; ++k) dst[m][k] = *(const PG8_LAS bf16x8*)(lds + PG8_SA(b, h) + aoff + m * 2048 + k * 1024); } while (0)
#define PG8_LDB(dst, b, h) do { _Pragma("unroll") for (int n = 0; n < 2; ++n) _Pragma("unroll") for (int k = 0; k < 2; ++k) dst[n][k] = *(const PG8_LAS bf16x8*)(lds + PG8_SB(b, h) + boff + n * 2048 + k * 1024); } while (0)
#define PG8_MMA(ai, bj, At, Bt) do { __builtin_amdgcn_s_setprio(1); _Pragma("unroll") for (int m = 0; m < 4; ++m) _Pragma("unroll") for (int n = 0; n < 2; ++n) _Pragma("unroll") for (int k = 0; k < 2; ++k) \
        acc[ai][bj][m][n] = __builtin_amdgcn_mfma_f32_16x16x32_bf16(Bt[n][k], At[m][k], acc[ai][bj][m][n], 0, 0, 0); __builtin_amdgcn_s_setprio(0); } while (0)
#define PG8_WAIT_V(n) asm volatile("s_waitcnt vmcnt(" #n ")" ::: "memory")
#define PG8_WAIT_L(n) asm volatile("s_waitcnt lgkmcnt(" #n ")" ::: "memory")
#define PG8_BAR __builtin_amdgcn_s_barrier()
#define PG8_SCHED __builtin_amdgcn_sched_barrier(0)
    Unit cur, nxt; int ui = 0;
    if (!S.next(0, cur)) return;
    f32x4 acc[2][2][4][2];
#pragma unroll
    for (int a = 0; a < 2; ++a)
#pragma unroll
        for (int b = 0; b < 2; ++b)
#pragma unroll
            for (int m = 0; m < 4; ++m)
#pragma unroll
                for (int n = 0; n < 2; ++n) acc[a][b][m][n] = (f32x4){0.f, 0.f, 0.f, 0.f};
    bf16x8 At[4][2], B0[2][2], B1[2][2];
    const char* cA = (const char*)g.A + (size_t)cur.pm * tstep + (size_t)cur.kofs * 2; const char* cB = (const char*)g.Bt + (size_t)cur.pn * tstep + (size_t)cur.kofs * 2;
    S.a_ready(cur);
    if constexpr (SP2) {
        PG8_STAGE(PG8_SB(0, 0), cB, voffB); PG8_STAGE(PG8_SB(0, 1), cB + hstep, voffB); PG8_STAGE(PG8_SA(0, 0), cA, voffA); PG8_STAGE(PG8_SA(0, 1), cA + hstep, voffA);
        if (wr == 1) PG8_BAR;
        PG8_WAIT_V(2); PG8_BAR;
        PG8_STAGE(PG8_SB(1, 0), cB + kstep, voffB); PG8_STAGE(PG8_SA(1, 0), cA + kstep, voffA); PG8_STAGE(PG8_SB(1, 1), cB + hstep + kstep, voffB);
        PG8_WAIT_V(6); PG8_BAR;
    } else {
        PG8_STAGE(PG8_SB(0, 0), cB, voffB); PG8_STAGE(PG8_SA(0, 0), cA, voffA); PG8_STAGE(PG8_SB(0, 1), cB + hstep, voffB); PG8_STAGE(PG8_SA(0, 1), cA + hstep, voffA);
        if (wr == 1) PG8_BAR;
        PG8_WAIT_V(4); PG8_BAR;
        PG8_STAGE(PG8_SB(1, 0), cB + kstep, voffB); PG8_STAGE(PG8_SA(1, 0), cA + kstep, voffA); PG8_STAGE(PG8_SB(1, 1), cB + hstep + kstep, voffB);
        PG8_WAIT_V(6); PG8_BAR;
    }
    for (;;) {
        const bool has_next = S.next(ui + 1, nxt);
        const char* nA = has_next ? (const char*)g.A + (size_t)nxt.pm * tstep + (size_t)nxt.kofs * 2 : cA; const char* nB = has_next ? (const char*)g.Bt + (size_t)nxt.pn * tstep + (size_t)nxt.kofs * 2 : cB;
        const int nt = cur.nt;
        for (int t = 0; t < nt; t += 2) {
            const bool last = (t == nt - 2);
            const char* a1 = cA + (size_t)(t + 1) * kstep;
            const char* a2 = last ? nA : cA + (size_t)(t + 2) * kstep; const char* b2 = last ? nB : cB + (size_t)(t + 2) * kstep;
            const char* a3 = a2 + kstep; const char* b3 = b2 + kstep;
            if (last && has_next) S.a_ready(nxt);
            if constexpr (SP2) {
            PG8_LDB(B0, 0, 0); PG8_LDB(B1, 0, 1); PG8_SCHED; PG8_LDA(At, 0, 0); PG8_STAGE(PG8_SA(1, 1), a1 + hstep, voffA);
            PG8_WAIT_V(8); PG8_WAIT_L(0); PG8_BAR; PG8_MMA(0, 0, At, B0); PG8_MMA(0, 1, At, B1); PG8_BAR; PG8_SCHED;
            PG8_LDA(At, 0, 1); PG8_STAGE(PG8_SB(0, 0), b2, voffB); PG8_STAGE(PG8_SB(0, 1), b2 + hstep, voffB); PG8_STAGE(PG8_SA(0, 0), a2, voffA);
            PG8_WAIT_V(8); PG8_WAIT_L(0); PG8_BAR; PG8_MMA(1, 0, At, B0); PG8_MMA(1, 1, At, B1); PG8_BAR; PG8_SCHED;
            PG8_LDB(B0, 1, 0); PG8_LDB(B1, 1, 1); PG8_SCHED; PG8_LDA(At, 1, 0); PG8_STAGE(PG8_SA(0, 1), a2 + hstep, voffA);
            PG8_WAIT_V(8); PG8_WAIT_L(0); PG8_BAR; PG8_MMA(0, 0, At, B0); PG8_MMA(0, 1, At, B1); PG8_BAR; PG8_SCHED;
            PG8_LDA(At, 1, 1); PG8_STAGE(PG8_SB(1, 0), b3, voffB); PG8_STAGE(PG8_SB(1, 1), b3 + hstep, voffB); PG8_STAGE(PG8_SA(1, 0), a3, voffA);
            PG8_WAIT_V(8); PG8_WAIT_L(0); PG8_BAR; PG8_MMA(1, 0, At, B0); PG8_MMA(1, 1, At, B1); PG8_BAR; PG8_SCHED;
            } else {
            PG8_LDB(B0, 0, 0); PG8_SCHED; PG8_LDA(At, 0, 0); PG8_STAGE(PG8_SA(1, 1), a1 + hstep, voffA);
            PG8_WAIT_L(8); PG8_BAR; PG8_WAIT_L(0); PG8_MMA(0, 0, At, B0); PG8_BAR; PG8_SCHED;
            PG8_LDB(B1, 0, 1); PG8_STAGE(PG8_SB(0, 0), b2, voffB);
            PG8_BAR; PG8_WAIT_L(0); PG8_MMA(0, 1, At, B1); PG8_BAR;
            PG8_LDA(At, 0, 1); PG8_STAGE(PG8_SA(0, 0), a2, voffA);
            PG8_BAR; PG8_WAIT_L(0); PG8_MMA(1, 0, At, B0); PG8_BAR; PG8_SCHED;
            PG8_STAGE(PG8_SB(0, 1), b2 + hstep, voffB);
            PG8_WAIT_V(6); PG8_BAR; PG8_MMA(1, 1, At, B1); PG8_BAR;
            PG8_LDB(B0, 1, 0); PG8_SCHED; PG8_LDA(At, 1, 0); PG8_STAGE(PG8_SA(0, 1), a2 + hstep, voffA);
            PG8_WAIT_L(8); PG8_BAR; PG8_WAIT_L(0); PG8_MMA(0, 0, At, B0); PG8_BAR; PG8_SCHED;
            PG8_LDB(B1, 1, 1); PG8_STAGE(PG8_SB(1, 0), b3, voffB);
            PG8_BAR; PG8_WAIT_L(0); PG8_MMA(0, 1, At, B1); PG8_BAR;
            PG8_LDA(At, 1, 1); PG8_STAGE(PG8_SA(1, 0), a3, voffA);
            PG8_BAR; PG8_WAIT_L(0); PG8_MMA(1, 0, At, B0); PG8_BAR; PG8_SCHED;
            PG8_STAGE(PG8_SB(1, 1), b3 + hstep, voffB);
            PG8_WAIT_V(6); PG8_BAR; PG8_MMA(1, 1, At, B1); PG8_BAR;
            }
        }
        if constexpr (ALIGN_EPI) { if (wr == 0) PG8_BAR; }
        if constexpr (!Epi::AFTER_DRAIN) { E(acc, cur, wr, wc, fr, fq); S.done(cur); }
        if (!has_next) break;
#pragma unroll
        for (int a = 0; a < 2; ++a)
#pragma unroll
            for (int b = 0; b < 2; ++b)
#pragma unroll
                for (int m = 0; m < 4; ++m)
#pragma unroll
                    for (int n = 0; n < 2; ++n) acc[a][b][m][n] = (f32x4){0.f, 0.f, 0.f, 0.f};
        cur = nxt; cA = nA; cB = nB; ++ui;
        if constexpr (ALIGN_EPI) { if (wr == 1) PG8_BAR; }
    }
    PG8_WAIT_V(0);
    if constexpr (!ALIGN_EPI) { if (wr == 0) PG8_BAR; }
    PG8_BAR;
    if constexpr (Epi::AFTER_DRAIN) { E.fused(acc, cur, wr, wc, fr, fq, lds, wid, lane); S.done(cur); }
#undef PG8_SA
#undef PG8_SB
#undef PG8_STAGE
#undef PG8_LDA
#undef PG8_LDB
#undef PG8_MMA
#undef PG8_WAIT_V
#undef PG8_WAIT_L
#undef PG8_BAR
#undef PG8_SCHED
}
}

using pg8::bf16_t; using pg8::bf16x8; using pg8::f32x4; using pg8::u32x4; using pg8::pk2; using pg8::pk8;
typedef float f32x16 __attribute__((ext_vector_type(16)));
typedef unsigned u32x2 __attribute__((ext_vector_type(2)));
constexpr int NWAVES = 8;
#define GAS __attribute__((address_space(1)))
#define LAS __attribute__((address_space(3)))
typedef GAS unsigned gu32;
#define RLX_AGENT __ATOMIC_RELAXED, __HIP_MEMORY_SCOPE_AGENT
#define LDS_WAIT() asm volatile("s_waitcnt lgkmcnt(0)" ::: "memory")
#define VM_WAIT() asm volatile("s_waitcnt vmcnt(0)" ::: "memory")

constexpr size_t MiB = 1u << 20;
constexpr size_t WS_CTL = 0, CTL_ZERO_BYTES = 1 * MiB;
constexpr size_t WS_TAB = 1 * MiB;
constexpr size_t WS_W1I = 2 * MiB;
constexpr size_t WS_W1O = WS_W1I + (size_t)2 * FF * DM * 2;
constexpr size_t WS_KN  = WS_W1I;
constexpr size_t WS_HB  = WS_W1O + (size_t)DM * FF * 2;
constexpr size_t WS_WIN = WS_HB + (size_t)MTOK * DM * 2;
constexpr size_t WS_WUQ = WS_WIN + (size_t)NIN * DM * 2;
constexpr size_t WS_WKV = WS_WUQ + (size_t)1536 * 512 * 2;
constexpr size_t WS_WBS = WS_WKV + (size_t)2048 * 512 * 2;
constexpr size_t WS_WBM = WS_WBS + (size_t)DM * 1024 * 2;
constexpr size_t WS_WO  = WS_WBM + (size_t)DM * 1024 * 2;
constexpr size_t WS_W2I = WS_WO + (size_t)DM * DM * 2;
constexpr size_t WS_W2O = WS_W2I + (size_t)2 * FF * DM * 2;
constexpr size_t WS_ACT = WS_W2O + (size_t)DM * FF * 2;
constexpr size_t WS_G   = WS_ACT;
constexpr size_t WS_Y   = WS_ACT + (size_t)MTOK * FF * 2;
constexpr size_t WS_VT  = WS_Y;
constexpr size_t WS_T   = WS_Y;
constexpr size_t WS_H   = WS_Y + (size_t)MTOK * DM * 4;
constexpr size_t WS_QM  = WS_H;
constexpr size_t WS_QS  = WS_H + (size_t)MTOK * DM * 4;
constexpr size_t WS_CQ  = WS_QS + (size_t)MTOK * 1024 * 2;
constexpr size_t WS_CKV = WS_CQ + (size_t)MTOK * 512 * 4;
constexpr size_t WS_KR  = WS_CKV + (size_t)MTOK * 512 * 4;
constexpr size_t WS_OSB = WS_CQ;
constexpr size_t WS_OML = WS_OSB + (size_t)MTOK * 1024 * 2;
constexpr size_t WS_CKA = WS_KR + (size_t)MTOK * 64 * 4;
constexpr size_t WS_CQB = WS_CKA + (size_t)KROWS * 512 * 2;
constexpr size_t WS_MG  = WS_CKA;
constexpr size_t WS_KRB = WS_CKA + (size_t)MTOK * DM * 2;
constexpr size_t WS_END = WS_KRB + (size_t)NPROMPT * 64 * 2;
static_assert(WS_OML + (size_t)MTOK * 1024 * 2 <= WS_CKA && WS_CQB + (size_t)MTOK * 512 * 2 <= WS_KRB && WS_KN + (size_t)(KROWS + 32) * 1024 * 2 <= WS_HB && WS_VT + (size_t)1024 * VPITCH * 2 <= WS_H, "d_ws map");
static_assert(WS_KN + (size_t)16 * NSAMPLE * DM * 4 <= WS_HB && WS_CQ + (size_t)32 * NSAMPLE * DM * 4 <= WS_KRB && WS_CQ + (size_t)16 * NSAMPLE * DM * 4 <= WS_CKA, "split-K slabs");
static_assert(WS_END <= (size_t)600 * MiB && (WS_W1O % 256) == 0 && (WS_CKA % 256) == 0 && (WS_CQB % 256) == 0, "d_ws map");
constexpr size_t O_YP = 0, O_YS = 16777216, O_KP = 17301504, O_VP = 25690112, O_CKVP = 34078720, O_KRP = 38273024, O_KS = 38797312, O_VS = 39059456, O_CKVS = 39321600, O_KRS = 39452672, O_END = 39469056;
constexpr int CW_TMO = 0, CW_BAR = 4096;
constexpr int RING_BYTES = 131072, LDSCTL_OFF = RING_BYTES, MISC_OFF = LDSCTL_OFF + 320, LDS_BYTES = 147456;
#define XB_TMO      128
#define XB_XCNT(j)  (256  + 64 * (j))
#define XB_XSUB(j)  (1280 + 64 * (j))
#define XB_XGEN(j)  (2304 + 64 * (j))
#define XB_TOP      3328
#define XB_TOPGEN   3392
#define XCD_BAR_WORDS 3456
#define XB_SPIN_CAP (1u << 18)

__device__ __forceinline__ unsigned xb_ld(unsigned* p)              { return __hip_atomic_load(p, __ATOMIC_RELAXED, __HIP_MEMORY_SCOPE_AGENT); }
__device__ __forceinline__ unsigned xb_add(unsigned* p, unsigned v) { return __hip_atomic_fetch_add(p, v, __ATOMIC_RELAXED, __HIP_MEMORY_SCOPE_AGENT); }
__device__ __forceinline__ unsigned xb_xcc_id() { return (unsigned)__builtin_amdgcn_s_getreg((3 << 11) | 20) & 0xFu; }
#define XB_SPIN(cond, bar) do { unsigned _sp = 0; while (cond) { __builtin_amdgcn_s_sleep(1); \
    if ((++_sp & 255u) == 0u) { if (xb_ld(&(bar)[XB_TMO])) break; if (_sp > XB_SPIN_CAP) { atomicAdd(&(bar)[XB_TMO], 1u); break; } } } } while (0)

struct XcdBarrier {
    unsigned* bar; unsigned x;
    volatile LAS unsigned* st;
};

__device__ __forceinline__ XcdBarrier xcd_barrier_post(unsigned* bar, volatile LAS unsigned* st) {
    XcdBarrier b; b.bar = bar; b.x = xb_xcc_id(); b.st = st;
    if (threadIdx.x == 0) (void)xb_add(&bar[XB_XCNT(b.x)], 1u);
    return b;
}
__device__ __forceinline__ void xcd_barrier_complete(unsigned* bar, unsigned x, unsigned& nloc, unsigned& nx) {
    const unsigned G = gridDim.x * gridDim.y * gridDim.z;
    unsigned sum, cnt, mine, sp = 0u;
    for (;;) {
        sum = 0u; cnt = 0u; mine = 0u;
#pragma unroll
        for (unsigned j = 0; j < 16; ++j) { const unsigned c = xb_ld(&bar[XB_XCNT(j)]); sum += c; cnt += (c > 0u) ? 1u : 0u; mine = (j == x) ? c : mine; }
        if (sum == G) break;
        __builtin_amdgcn_s_sleep(1);
        if ((++sp & 255u) == 0u) { if (xb_ld(&bar[XB_TMO])) break; if (sp > XB_SPIN_CAP) { atomicAdd(&bar[XB_TMO], 1u); break; } }
    }
    nloc = mine > 0u ? mine : 1u; nx = cnt > 0u ? cnt : 1u;
}

__device__ __forceinline__ void xcd_barrier(const XcdBarrier& b) {
    asm volatile("s_waitcnt vmcnt(0)" ::: "memory");
    __syncthreads();
    if (threadIdx.x == 0) {
        unsigned* bar = b.bar;
        __builtin_amdgcn_s_waitcnt(0);
        unsigned nloc = b.st[0], nx = b.st[1];
        if (nloc == 0u) { xcd_barrier_complete(bar, b.x, nloc, nx); b.st[0] = nloc; b.st[1] = nx; }
        const unsigned old = xb_add(&bar[XB_XSUB(b.x)], 1u);
        const unsigned gen = old / nloc;
        if (old + 1u == (gen + 1u) * nloc) {
            __builtin_amdgcn_fence(__ATOMIC_RELEASE, "agent");
            asm volatile("s_waitcnt vmcnt(0)" ::: "memory");
            const unsigned og = xb_add(&bar[XB_TOP], 1u);
            const unsigned tg = og / nx;
            if (og + 1u == (tg + 1u) * nx) xb_add(&bar[XB_TOPGEN], 1u);
            else XB_SPIN(xb_ld(&bar[XB_TOPGEN]) == tg, bar);
            __builtin_amdgcn_fence(__ATOMIC_ACQUIRE, "agent");
            xb_add(&bar[XB_XGEN(b.x)], 1u);
            asm volatile("s_waitcnt vmcnt(0)" ::: "memory");
        } else {
            XB_SPIN(xb_ld(&bar[XB_XGEN(b.x)]) == gen, bar);
            __builtin_amdgcn_fence(__ATOMIC_ACQUIRE, "agent");
            asm volatile("s_waitcnt vmcnt(0)" ::: "memory");
        }
    }
    __syncthreads();
}

__device__ __forceinline__ float wave_sum(float v) {
#pragma unroll
    for (int o = 1; o < 64; o <<= 1) v += __shfl_xor(v, o);
    return v;
}
__device__ __forceinline__ void transpose_item(const float* W, int ldw, int k0, int n0, bf16_t* WT, int ldt, int drow0, LAS float* scr, int lane) {
#pragma unroll 8
    for (int i = 0; i < 32; ++i) { const int kk = 2 * i + (lane >> 5); scr[kk * 33 + (lane & 31)] = W[(size_t)(k0 + kk) * ldw + n0 + (lane & 31)]; }
    LDS_WAIT(); asm volatile("" ::: "memory");
    const int c = lane & 7;
#pragma unroll
    for (int j = 0; j < 4; ++j) { const int n = (lane >> 3) + 8 * j; const LAS float* s = scr + (8 * c) * 33 + n;
        u32x4 o; o.x = pk2(s[0 * 33], s[1 * 33]); o.y = pk2(s[2 * 33], s[3 * 33]); o.z = pk2(s[4 * 33], s[5 * 33]); o.w = pk2(s[6 * 33], s[7 * 33]);
        *(u32x4*)(WT + (size_t)(drow0 + n) * ldt + k0 + 8 * c) = o; }
    LDS_WAIT(); asm volatile("" ::: "memory");
}
template <int MAP> __device__ __forceinline__ int map_row(int n0) {
    if (MAP == 1) { const int j = n0 < FF ? n0 : n0 - FF; return ((j >> 7) << 8) + (j & 127) + (n0 < FF ? 0 : 128); }
    if (MAP == 2) { return n0 < 4096 ? n0 : (n0 < 4160 ? 8192 + (n0 - 4096) : 4096 + (n0 - 4160)); }
    if (MAP == 3) { const int h = n0 >> 8, r = n0 & 255; return r < 128 ? h * 128 + r : 1024 + h * 128 + (r - 128); }
    return n0;
}
template <int MAP> __device__ __forceinline__ void transpose_matrix(const float* W, int K, int N, bf16_t* WT, LAS float* scr, int gw, int NGW, int lane) {
    const int nnb = N / 32, nit = (K / 64) * nnb;
    for (int it = gw; it < nit; it += NGW) { const int kb = it / nnb, nb = it - kb * nnb; transpose_item(W, N, kb * 64, nb * 32, WT, K, map_row<MAP>(nb * 32), scr, lane); }
}
__device__ __forceinline__ int tok_pos(int m) { return m < NPROMPT ? (m & (SEQ - 1)) : PAST + ((m - NPROMPT) & (DEC_T - 1)); }
__device__ __forceinline__ int tok_krow(int m) { return m < NPROMPT ? m : NPROMPT + ((m - NPROMPT) >> 4) * KEYS_S + PAST + ((m - NPROMPT) & 15); }

__device__ __forceinline__ void ln_row_finish(f32x4 (&v)[8], const float* gam, const float* bet, float* frow, bf16_t* brow, int lane) {
    float s = 0.f;
#pragma unroll
    for (int j = 0; j < 8; ++j) s += (v[j][0] + v[j][1]) + (v[j][2] + v[j][3]);
    const float mean = wave_sum(s) * (1.f / DM); float s2 = 0.f;
#pragma unroll
    for (int j = 0; j < 8; ++j) { v[j] = v[j] - mean; s2 += (v[j][0] * v[j][0] + v[j][1] * v[j][1]) + (v[j][2] * v[j][2] + v[j][3] * v[j][3]); }
    const float rstd = 1.f / sqrtf(wave_sum(s2) * (1.f / DM) + LN_EPS);
    f32x4* fo = (f32x4*)frow + lane; u32x2* bo = (u32x2*)brow + lane;
#pragma unroll
    for (int j = 0; j < 8; ++j) { const f32x4 g = ((const f32x4*)gam)[64 * j + lane], b = ((const f32x4*)bet)[64 * j + lane]; const f32x4 o = v[j] * rstd * g + b;
        if (frow) fo[64 * j] = o; if (brow) { u32x2 w; w.x = pk2(o[0], o[1]); w.y = pk2(o[2], o[3]); bo[64 * j] = w; } }
}
template <int NCH, bool RBF>
__device__ __forceinline__ void ln_phase(LAS unsigned char* lds, const bf16_t* Y, const float* gam, const float* bet, float* F0, float* F1, bf16_t* HBo, const float* slab, const void* R1, float alpha, float sc, int bx, int G, int tid, int wave, int lane) {
    const int gw = bx * NWAVES + wave, NGW = G * NWAVES;
    for (int sr = bx; sr < NSAMPLE; sr += G) {
        const f32x4* sp = (const f32x4*)(slab + (size_t)sr * DM) + tid;
        f32x4 a = sp[0];
#pragma unroll 8
        for (int c = 1; c < NCH; ++c) a += sp[(size_t)c * (NSAMPLE * DM / 4)];
        f32x4 rr;
        if (RBF) { const u32x2 w = ((const u32x2*)((const bf16_t*)R1 + (size_t)sr * DM))[tid]; rr = (f32x4){pg8::bf_lo(w.x), pg8::bf_hi(w.x), pg8::bf_lo(w.y), pg8::bf_hi(w.y)}; }
        else rr = ((const f32x4*)((const float*)R1 + (size_t)sr * DM))[tid];
        ((LAS f32x4*)lds)[tid] = rr * alpha + a * sc;
        __syncthreads();
        if (wave == 0) { f32x4 v[8];
#pragma unroll
            for (int j = 0; j < 8; ++j) v[j] = ((const LAS f32x4*)lds)[64 * j + lane];
            ln_row_finish(v, gam, bet, F1 ? F1 + (size_t)sr * DM : nullptr, HBo ? HBo + (size_t)(NPROMPT + sr) * DM : nullptr, lane); }
        __syncthreads();
    }
    u32x2 wn[8];
    if (gw < NPROMPT) { const u32x2* yr = (const u32x2*)(Y + (size_t)gw * DM) + lane;
#pragma unroll
        for (int j = 0; j < 8; ++j) wn[j] = yr[64 * j]; }
    for (int m = gw; m < NPROMPT; m += NGW) {
        f32x4 v[8];
#pragma unroll
        for (int j = 0; j < 8; ++j) v[j] = (f32x4){pg8::bf_lo(wn[j].x), pg8::bf_hi(wn[j].x), pg8::bf_lo(wn[j].y), pg8::bf_hi(wn[j].y)};
        if (m + NGW < NPROMPT) { const u32x2* yr = (const u32x2*)(Y + (size_t)(m + NGW) * DM) + lane;
#pragma unroll
            for (int j = 0; j < 8; ++j) wn[j] = yr[64 * j]; }
        ln_row_finish(v, gam, bet, F0 ? F0 + (size_t)m * DM : nullptr, HBo ? HBo + (size_t)m * DM : nullptr, lane);
    }
}

#define MFMA32(a, b, c) __builtin_amdgcn_mfma_f32_32x32x16_bf16((a), (b), (c), 0, 0, 0)
__device__ __forceinline__ bf16x8 pack8f(const f32x4 a, const f32x4 b) { return __builtin_bit_cast(bf16x8, pk8(a, b)); }
__device__ __forceinline__ int pi32(int r) { return (r & ~12) | ((r & 4) << 1) | ((r & 8) >> 1); }
__device__ __forceinline__ void store_ot(bf16_t* op, const f32x16 (&o)[4], float sc, int hi) {
#pragma unroll
    for (int dt = 0; dt < 4; ++dt)
#pragma unroll
        for (int g = 0; g < 4; ++g) { u32x2 w; w.x = pk2(o[dt][4 * g] * sc, o[dt][4 * g + 1] * sc); w.y = pk2(o[dt][4 * g + 2] * sc, o[dt][4 * g + 3] * sc);
            *(u32x2*)(op + dt * 32 + 8 * g + 4 * hi) = w; }
}

__device__ __forceinline__ void sb_scores(const bf16x8 (&kf)[8], const bf16x8 (&qf)[8], bool diag, int key0, int qpos, int hi, float& R, bf16x8& pf0, bf16x8& pf1) {
    f32x16 st;
#pragma unroll
    for (int i = 0; i < 16; ++i) st[i] = 0.f;
#pragma unroll
    for (int ks = 0; ks < 8; ++ks) st = MFMA32(kf[ks], qf[ks], st);
    float l1[16], lb[16];
#pragma unroll
    for (int i = 0; i < 16; ++i) { const float zz = st[i]; const float e = __builtin_amdgcn_exp2f(-__builtin_fabsf(zz)); const float sp = fmaxf(zz, 0.f) + __builtin_amdgcn_logf(1.f + e);
        l1[i] = -sp; lb[i] = zz - sp;
        if (diag) { const int key = key0 + 16 * (i >> 3) + 8 * hi + (i & 7); const bool vis = key < qpos; l1[i] = vis ? l1[i] : 0.f; lb[i] = vis ? lb[i] : -INFINITY; } }
    float g0 = 0.f, g1 = 0.f;
#pragma unroll
    for (int i = 0; i < 8; ++i) { g0 += l1[i]; g1 += l1[8 + i]; }
    const float pg0 = __shfl_xor(g0, 32), pg1 = __shfl_xor(g1, 32);
    float p[16];
    { float run = R + (hi ? 0.f : pg1);
#pragma unroll
      for (int i = 15; i >= 8; --i) { p[i] = __builtin_amdgcn_exp2f(lb[i] + run); run += l1[i]; }
      run = R + g1 + pg1 + (hi ? 0.f : pg0);
#pragma unroll
      for (int i = 7; i >= 0; --i) { p[i] = __builtin_amdgcn_exp2f(lb[i] + run); run += l1[i]; } }
    R += (g0 + g1) + (pg0 + pg1);
    pf0 = pack8f((f32x4){p[0], p[1], p[2], p[3]}, (f32x4){p[4], p[5], p[6], p[7]}); pf1 = pack8f((f32x4){p[8], p[9], p[10], p[11]}, (f32x4){p[12], p[13], p[14], p[15]});
}
constexpr int SK_PITCH = 272, SV_PITCH = 136, SK_BYTES = 64 * SK_PITCH, SV_BYTES = 128 * SV_PITCH, ST_BYTES = SK_BYTES + SV_BYTES;
static_assert(2 * ST_BYTES + 64 <= RING_BYTES && 8 * 32 * 4 + 9 * 64 * 32 * 4 <= RING_BYTES, "SB LDS");
__device__ __forceinline__ void sb_prompt_unit(LAS unsigned char* lds, int b, int h, int j, const bf16_t* QS, const float* Kp, const float* Vp, bf16_t* OSB, int tid, int lane, int wave) {
    const int r = lane & 31, hi = lane >> 5;
    const int Q0 = j * 256, qpos = Q0 + 32 * wave + r, qrow = b * SEQ + qpos, NT = (Q0 + 256) / 64;
    const bf16_t* qp = QS + (size_t)qrow * 1024 + h * 128 + 8 * hi;
    bf16x8 qf[8];
#pragma unroll
    for (int ks = 0; ks < 8; ++ks) qf[ks] = *(const bf16x8*)(qp + 16 * ks);
    f32x16 o[4];
#pragma unroll
    for (int dt = 0; dt < 4; ++dt)
#pragma unroll
        for (int i = 0; i < 16; ++i) o[dt][i] = 0.f;
    float R = 0.f; int done = 0;
    volatile LAS int* flags = (volatile LAS int*)(lds + 2 * ST_BYTES);
    const float* gK = Kp + (size_t)(b * SEQ) * 1024 + h * 128;
    const float* gV = Vp + (size_t)(b * SEQ) * 1024 + h * 128;
    f32x4 ka[2][2]; float va[8][2];
#define SB_ISSUE(t) do { const int kb_ = Q0 + 256 - 64 * ((t) + 1); \
        _Pragma("unroll") for (int jj = 0; jj < 2; ++jj) { const int idx = tid + 512 * jj; const float* p_ = gK + (size_t)(kb_ + (idx >> 4)) * 1024 + (idx & 15) * 8; ka[jj][0] = *(const f32x4*)p_; ka[jj][1] = *(const f32x4*)(p_ + 4); } \
        _Pragma("unroll") for (int jj = 0; jj < 8; ++jj) { const int idx = tid + 512 * jj; const float* p_ = gV + (size_t)(kb_ + 2 * (idx >> 7)) * 1024 + (idx & 127); va[jj][0] = p_[0]; va[jj][1] = p_[1024]; } } while (0)
#define SB_COMMIT(buf) do { LAS unsigned char* B_ = lds + (buf) * ST_BYTES; \
        _Pragma("unroll") for (int jj = 0; jj < 2; ++jj) { const int idx = tid + 512 * jj; *(LAS u32x4*)(B_ + (idx >> 4) * SK_PITCH + (idx & 15) * 16) = pk8(ka[jj][0], ka[jj][1]); } \
        _Pragma("unroll") for (int jj = 0; jj < 8; ++jj) { const int idx = tid + 512 * jj; *(LAS unsigned*)(B_ + SK_BYTES + (idx & 127) * SV_PITCH + (idx >> 7) * 4) = pk2(va[jj][0], va[jj][1]); } } while (0)
    const int pr = pi32(r);
    SB_ISSUE(0); SB_COMMIT(0); __syncthreads();
    for (int t = 0; t < NT; ++t) {
        if (t + 1 < NT) SB_ISSUE(t + 1);
        const int kbase = Q0 + 256 - 64 * (t + 1);
        const LAS unsigned char* Bt = lds + (t & 1) * ST_BYTES;
#pragma unroll
        for (int sub = 1; sub >= 0; --sub) {
            const int key0 = kbase + 32 * sub;
            if (!done && key0 <= Q0 + 32 * wave) {
                bf16x8 kf[8];
                { const LAS unsigned char* kp = Bt + (32 * sub + pr) * SK_PITCH + hi * 16;
#pragma unroll
                  for (int ks = 0; ks < 8; ++ks) kf[ks] = *(const LAS bf16x8*)(kp + ks * 32); }
                bf16x8 pf0, pf1; sb_scores(kf, qf, key0 == Q0 + 32 * wave, key0, qpos, hi, R, pf0, pf1);
                const LAS unsigned char* vp = Bt + SK_BYTES + r * SV_PITCH + (32 * sub + 8 * hi) * 2;
#pragma unroll
                for (int dt = 0; dt < 4; ++dt) {
                    const u32x2 a0 = *(const LAS u32x2*)(vp + dt * 32 * SV_PITCH), a1 = *(const LAS u32x2*)(vp + dt * 32 * SV_PITCH + 8), c0 = *(const LAS u32x2*)(vp + dt * 32 * SV_PITCH + 32), c1 = *(const LAS u32x2*)(vp + dt * 32 * SV_PITCH + 40);
                    o[dt] = MFMA32(__builtin_bit_cast(bf16x8, (u32x4){a0.x, a0.y, a1.x, a1.y}), pf0, o[dt]); o[dt] = MFMA32(__builtin_bit_cast(bf16x8, (u32x4){c0.x, c0.y, c1.x, c1.y}), pf1, o[dt]); }
                if (__all(R < -160.f)) done = 1;
            }
        }
        if (lane == 0) flags[(t & 1) * 8 + wave] = done;
        if (t + 1 < NT) SB_COMMIT((t + 1) & 1);
        __syncthreads();
        int alld = 1;
#pragma unroll
        for (int w = 0; w < 8; ++w) alld &= flags[(t & 1) * 8 + w];
        if (alld) break;
    }
#undef SB_ISSUE
#undef SB_COMMIT
    store_ot(OSB + (size_t)qrow * 1024 + h * 128, o, 1.f, hi);
    __syncthreads();
}
__device__ __forceinline__ void sb_sample_unit(LAS unsigned char* lds, int b, int h, const bf16_t* QS, const float* cK, const float* cV, const float* nK, const float* nV, bf16_t* OSB, int lane, int wave) {
    const int r = lane & 31, hi = lane >> 5;
    const int qi = r < DEC_T ? r : DEC_T - 1, qpos = PAST + qi, qrow = NPROMPT + b * DEC_T + qi, cl = hi * 16 + (r & 15);
    const bool valid = r < DEC_T;
    const bf16_t* qp = QS + (size_t)qrow * 1024 + h * 128 + 8 * hi;
    bf16x8 qf[8];
#pragma unroll
    for (int ks = 0; ks < 8; ++ks) qf[ks] = *(const bf16x8*)(qp + 16 * ks);
    float Rcarry = 0.f;
    LAS float* RT = (LAS float*)lds;
    LAS float* OP = (LAS float*)(lds + 8 * 32 * 4);
    LAS float* OA = OP + 8 * 64 * 32;
    if (wave == 0 && valid) {
#pragma unroll
        for (int i = 0; i < 64; ++i) OA[i * 32 + cl] = 0.f; }
    const int pr = pi32(r);
    for (int base = PAST / 32; base >= 0; base -= NWAVES) {
        const int kt = base - wave;
        f32x16 o[4];
#pragma unroll
        for (int dt = 0; dt < 4; ++dt)
#pragma unroll
            for (int i = 0; i < 16; ++i) o[dt][i] = 0.f;
        float Rl = 0.f;
        if (kt >= 0) {
            const float* Kb; const float* Vb; int nvalid = 32;
            if (kt < PAST / 32) { const size_t off = ((size_t)b * PAST + kt * 32) * 1024 + h * 128; Kb = cK + off; Vb = cV + off; }
            else { const size_t off = (size_t)(b * DEC_T) * 1024 + h * 128; Kb = nK + off; Vb = nV + off; nvalid = DEC_T; }
            bf16x8 kf[8];
            { const float* kr = Kb + (size_t)(pr < nvalid ? pr : nvalid - 1) * 1024 + 8 * hi;
#pragma unroll
              for (int ks = 0; ks < 8; ++ks) kf[ks] = pack8f(*(const f32x4*)(kr + 16 * ks), *(const f32x4*)(kr + 16 * ks + 4)); }
            bf16x8 pf0, pf1; sb_scores(kf, qf, kt == PAST / 32, kt * 32, qpos, hi, Rl, pf0, pf1);
#pragma unroll
            for (int s2 = 0; s2 < 2; ++s2) { float vv[4][8];
#pragma unroll
                for (int jj = 0; jj < 8; ++jj) { const int kl = 16 * s2 + 8 * hi + jj; const float* vp = Vb + (size_t)(kl < nvalid ? kl : nvalid - 1) * 1024 + r;
#pragma unroll
                    for (int dt = 0; dt < 4; ++dt) vv[dt][jj] = vp[32 * dt]; }
#pragma unroll
                for (int dt = 0; dt < 4; ++dt) o[dt] = MFMA32(pack8f((f32x4){vv[dt][0], vv[dt][1], vv[dt][2], vv[dt][3]}, (f32x4){vv[dt][4], vv[dt][5], vv[dt][6], vv[dt][7]}), s2 ? pf1 : pf0, o[dt]); }
        }
        if (valid) RT[wave * 32 + cl] = Rl;
        __syncthreads();
        float Rpre = Rcarry, Rall = Rcarry;
#pragma unroll
        for (int w = 0; w < NWAVES; ++w) { const float x = RT[w * 32 + cl]; Rall += x; Rpre += (w < wave) ? x : 0.f; }
        const float sc = __builtin_amdgcn_exp2f(Rpre);
        if (valid) {
#pragma unroll
            for (int dt = 0; dt < 4; ++dt)
#pragma unroll
                for (int i = 0; i < 16; ++i) OP[(wave * 64 + dt * 16 + i) * 32 + cl] = o[dt][i] * sc; }
        __syncthreads();
        if (wave == 0 && valid) {
#pragma unroll 4
            for (int i = 0; i < 64; ++i) { float a = OA[i * 32 + cl];
#pragma unroll
                for (int w = 0; w < NWAVES; ++w) a += OP[(w * 64 + i) * 32 + cl];
                OA[i * 32 + cl] = a; } }
        Rcarry = Rall;
        __syncthreads();
        if (__all(Rcarry < -160.f)) break;
    }
    if (wave == 0 && valid) { f32x16 oacc[4];
#pragma unroll
        for (int dt = 0; dt < 4; ++dt)
#pragma unroll
            for (int i = 0; i < 16; ++i) oacc[dt][i] = OA[(dt * 16 + i) * 32 + cl];
        store_ot(OSB + (size_t)qrow * 1024 + h * 128, oacc, 1.f, hi); }
    __syncthreads();
}

__device__ __forceinline__ void mla_softmax_pv_prep(const f32x16& st, f32x16 (&o)[4], float& mrun, float& lsum, bf16x8& pf0, bf16x8& pf1) {
    float mx = st[0];
#pragma unroll
    for (int i = 1; i < 16; ++i) mx = fmaxf(mx, st[i]);
    mx = fmaxf(mx, __shfl_xor(mx, 32));
    if (!__all(mx - mrun <= 6.f)) { const float mnew = fmaxf(mrun, mx), alpha = __builtin_amdgcn_exp2f(mrun - mnew); lsum *= alpha; mrun = mnew;
#pragma unroll
        for (int dt = 0; dt < 4; ++dt)
#pragma unroll
            for (int i = 0; i < 16; ++i) o[dt][i] *= alpha; }
    float p[16], ps = 0.f;
#pragma unroll
    for (int i = 0; i < 16; ++i) { p[i] = __builtin_amdgcn_exp2f(st[i] - mrun); ps += p[i]; }
    lsum += ps;
    pf0 = pack8f((f32x4){p[0], p[1], p[2], p[3]}, (f32x4){p[4], p[5], p[6], p[7]}); pf1 = pack8f((f32x4){p[8], p[9], p[10], p[11]}, (f32x4){p[12], p[13], p[14], p[15]});
}
constexpr int MK_PITCH = 400, MV_PITCH = 144, MK_BYTES = 64 * MK_PITCH, MV_BYTES = 128 * MV_PITCH, MT_BYTES = MK_BYTES + MV_BYTES;
static_assert(2 * MT_BYTES <= RING_BYTES && 4 * 64 * 66 * 4 <= RING_BYTES, "MLA LDS");
__device__ __forceinline__ void mla_prompt_unit(LAS unsigned char* lds, int b, int h, int qi, const bf16_t* QM, const bf16_t* KN, const bf16_t* VT, const bf16_t* krP, bf16_t* OML, int tid, int lane, int wave) {
    const int r = lane & 31, hi = lane >> 5, qsub = wave & 3, kgrp = wave >> 2;
    const int qrow = b * SEQ + qi * 128 + qsub * 32 + r, NT = 2 * qi + 2, ntw = (qsub < 2) ? NT - 1 : NT, krow0 = b * SEQ;
    const bf16_t* qp = QM + (size_t)qrow * 1536 + h * 192 + 8 * hi;
    bf16x8 qf[12];
#pragma unroll
    for (int ks = 0; ks < 12; ++ks) qf[ks] = *(const bf16x8*)(qp + 16 * ks);
    f32x16 o[4];
#pragma unroll
    for (int dt = 0; dt < 4; ++dt)
#pragma unroll
        for (int i = 0; i < 16; ++i) o[dt][i] = 0.f;
    float mrun = -1e30f, lsum = 0.f;
    const int kr0 = tid >> 4, kc0 = tid & 15, rr = tid >> 3, rc = tid & 7;
    const bf16_t* gk = KN + (size_t)(krow0 + kr0) * 1024 + h * 128 + kc0 * 8;
    const bf16_t* gr = krP + (size_t)(krow0 + rr) * 64 + 8 * rc;
    const bf16_t* gv = VT + (size_t)(h * 128 + rr) * VPITCH + krow0 + rc * 8;
    const int lk = kr0 * MK_PITCH + kc0 * 16, lr = rr * MK_PITCH + 256 + rc * 16, lv = MK_BYTES + rr * MV_PITCH + rc * 16;
    u32x4 ak0, ak1, av0, av1, bk0, bk1, bv0, bv1, ar1, br1;
#define MLA_ISSUE(P, t) do { P##k0 = *(const u32x4*)(gk + (size_t)(t) * 65536); P##k1 = *(const u32x4*)(gk + (size_t)(t) * 65536 + 32768); P##r1 = *(const u32x4*)(gr + (size_t)(t) * 4096); \
        P##v0 = *(const u32x4*)(gv + (t) * 64); P##v1 = *(const u32x4*)(gv + (t) * 64 + (size_t)64 * VPITCH); } while (0)
#define MLA_COMMIT(P, buf) do { LAS unsigned char* B_ = lds + (buf) * MT_BYTES; *(LAS u32x4*)(B_ + lk) = P##k0; *(LAS u32x4*)(B_ + lk + 32 * MK_PITCH) = P##k1; \
        *(LAS u32x4*)(B_ + lr) = P##r1; *(LAS u32x4*)(B_ + lv) = P##v0; *(LAS u32x4*)(B_ + lv + 64 * MV_PITCH) = P##v1; } while (0)
#define MLA_COMPUTE(t, buf) do { if ((t) < ntw) { const LAS unsigned char* Bt = lds + (buf) * MT_BYTES; f32x16 st; \
            _Pragma("unroll") for (int i = 0; i < 16; ++i) st[i] = 0.f; \
            _Pragma("unroll") for (int ks = 0; ks < 12; ++ks) st = MFMA32(*(const LAS bf16x8*)(Bt + ko + ks * 32), qf[ks], st); \
            bf16x8 pf0, pf1; mla_softmax_pv_prep(st, o, mrun, lsum, pf0, pf1); \
            _Pragma("unroll") for (int dt = 0; dt < 4; ++dt) { o[dt] = MFMA32(*(const LAS bf16x8*)(Bt + vo + dt * 32 * MV_PITCH), pf0, o[dt]); o[dt] = MFMA32(*(const LAS bf16x8*)(Bt + vo + dt * 32 * MV_PITCH + 32), pf1, o[dt]); } } } while (0)
    const int pr = pi32(r);
    const int ko = (32 * kgrp + pr) * MK_PITCH + hi * 16, vo = MK_BYTES + r * MV_PITCH + (32 * kgrp + 8 * hi) * 2;
    MLA_ISSUE(a, 0); MLA_ISSUE(b, 1); MLA_COMMIT(a, 0); __syncthreads();
    for (int t = 0; t < NT; t += 2) {
        if (t + 2 < NT) MLA_ISSUE(a, t + 2);
        MLA_COMPUTE(t, 0);
        MLA_COMMIT(b, 1);
        __syncthreads();
        if (t + 3 < NT) MLA_ISSUE(b, t + 3);
        MLA_COMPUTE(t + 1, 1);
        if (t + 2 < NT) MLA_COMMIT(a, 0);
        __syncthreads();
    }
#undef MLA_ISSUE
#undef MLA_COMMIT
#undef MLA_COMPUTE
    LAS float* X = (LAS float*)lds;
    if (kgrp == 1) { X[(0 * 4 + qsub) * 64 + lane] = mrun; X[(1 * 4 + qsub) * 64 + lane] = lsum;
#pragma unroll
        for (int dt = 0; dt < 4; ++dt)
#pragma unroll
            for (int i = 0; i < 16; ++i) X[((2 + dt * 16 + i) * 4 + qsub) * 64 + lane] = o[dt][i]; }
    __syncthreads();
    if (kgrp == 0) { const float m2 = X[(0 * 4 + qsub) * 64 + lane], l2 = X[(1 * 4 + qsub) * 64 + lane]; const float mnew = fmaxf(mrun, m2), a1 = __builtin_amdgcn_exp2f(mrun - mnew), a2 = __builtin_amdgcn_exp2f(m2 - mnew);
        lsum = lsum * a1 + l2 * a2;
#pragma unroll
        for (int dt = 0; dt < 4; ++dt)
#pragma unroll
            for (int i = 0; i < 16; ++i) o[dt][i] = o[dt][i] * a1 + X[((2 + dt * 16 + i) * 4 + qsub) * 64 + lane] * a2;
        lsum += __shfl_xor(lsum, 32);
        store_ot(OML + (size_t)qrow * 1024 + h * 128, o, 1.f / lsum, hi); }
    __syncthreads();
}
__device__ __forceinline__ void mla_sample_unit(LAS unsigned char* lds, int b, int h, const bf16_t* QM, const bf16_t* KN, const bf16_t* VT, const float* krC, const float* krN, bf16_t* OML, int lane, int wave) {
    const int r = lane & 31, hi = lane >> 5;
    const int qi = r < DEC_T ? r : DEC_T - 1, qrow = NPROMPT + b * DEC_T + qi, krow0 = NPROMPT + b * KEYS_S;
    const bf16_t* qp = QM + (size_t)qrow * 1536 + h * 192 + 8 * hi;
    bf16x8 qf[12];
#pragma unroll
    for (int ks = 0; ks < 12; ++ks) qf[ks] = *(const bf16x8*)(qp + 16 * ks);
    f32x16 o[4];
#pragma unroll
    for (int dt = 0; dt < 4; ++dt)
#pragma unroll
        for (int i = 0; i < 16; ++i) o[dt][i] = 0.f;
    float mrun = -1e30f, lsum = 0.f;
    const int pr = pi32(r);
    const bf16_t* vbase = VT + (size_t)(h * 128 + r) * VPITCH + krow0 + 8 * hi;
    for (int kt = wave; kt < PAST / 32 + 1; kt += NWAVES) {
        f32x16 st;
#pragma unroll
        for (int i = 0; i < 16; ++i) st[i] = 0.f;
        { const bf16_t* kp = KN + (size_t)(krow0 + kt * 32 + pr) * 1024 + h * 128 + 8 * hi;
#pragma unroll
          for (int ks = 0; ks < 8; ++ks) st = MFMA32(*(const bf16x8*)(kp + 16 * ks), qf[ks], st);
          const float* rp = (kt < PAST / 32) ? krC + ((size_t)b * PAST + kt * 32 + pr) * 64 : krN + (size_t)(b * DEC_T + (pr < DEC_T ? pr : DEC_T - 1)) * 64;
#pragma unroll
          for (int ks = 0; ks < 4; ++ks) { const f32x4 x1 = *(const f32x4*)(rp + 8 * ks + 4 * hi), x2 = *(const f32x4*)(rp + 32 + 8 * ks + 4 * hi);
              st = MFMA32(pack8f((f32x4){x1[0], x2[0], x1[1], x2[1]}, (f32x4){x1[2], x2[2], x1[3], x2[3]}), qf[8 + ks], st); } }
        if (kt == PAST / 32) {
#pragma unroll
            for (int i = 8; i < 16; ++i) st[i] = -INFINITY;
        }
        __builtin_amdgcn_sched_barrier(0);
        bf16x8 pf0, pf1; mla_softmax_pv_prep(st, o, mrun, lsum, pf0, pf1);
        __builtin_amdgcn_sched_barrier(0);
        const bf16_t* vp = vbase + kt * 32;
#pragma unroll
        for (int dt = 0; dt < 4; ++dt) { o[dt] = MFMA32(*(const bf16x8*)(vp + (size_t)dt * 32 * VPITCH), pf0, o[dt]); o[dt] = MFMA32(*(const bf16x8*)(vp + (size_t)dt * 32 * VPITCH + 16), pf1, o[dt]); }
    }
    LAS float* X = (LAS float*)lds;
    const int cl = hi * 16 + r;
    if (wave > 0 && r < DEC_T) { X[(0 * 7 + wave - 1) * 32 + cl] = mrun; X[(1 * 7 + wave - 1) * 32 + cl] = lsum;
#pragma unroll
        for (int dt = 0; dt < 4; ++dt)
#pragma unroll
            for (int i = 0; i < 16; ++i) X[((2 + dt * 16 + i) * 7 + wave - 1) * 32 + cl] = o[dt][i]; }
    __syncthreads();
    if (wave == 0) {
        if (r < DEC_T) {
#pragma unroll 1
            for (int w = 0; w < 7; ++w) { const float m2 = X[(0 * 7 + w) * 32 + cl], l2 = X[(1 * 7 + w) * 32 + cl]; const float mnew = fmaxf(mrun, m2), a1 = __builtin_amdgcn_exp2f(mrun - mnew), a2 = __builtin_amdgcn_exp2f(m2 - mnew);
                lsum = lsum * a1 + l2 * a2; mrun = mnew;
#pragma unroll
                for (int dt = 0; dt < 4; ++dt)
#pragma unroll
                    for (int i = 0; i < 16; ++i) o[dt][i] = o[dt][i] * a1 + X[((2 + dt * 16 + i) * 7 + w) * 32 + cl] * a2; }
        }
        lsum += __shfl_xor(lsum, 32);
        if (r < DEC_T) store_ot(OML + (size_t)qrow * 1024 + h * 128, o, 1.f / lsum, hi);
    }
    __syncthreads();
}

#ifndef MK_N_LAUNCHES
#define MK_N_LAUNCHES 1
#endif
constexpr int NPHASE = 15;
constexpr int N_LAUNCHES = MK_N_LAUNCHES;
static_assert(N_LAUNCHES == 1 || N_LAUNCHES == NPHASE, "MK_N_LAUNCHES is 1 or 15");
__device__ unsigned g_bar[XCD_BAR_WORDS + 64];
constexpr int GB_DONE = XCD_BAR_WORDS;
struct Args { const float* in[25]; float* out; unsigned char* ws; int ph_lo, ph_hi; };
static_assert(sizeof(Args) == 27 * 8 + 8, "Args has no padding");

__global__ void __launch_bounds__(NWAVES * 64, 2) fwd_kernel(Args args) {
    extern __shared__ __attribute__((aligned(16))) unsigned char lds_raw[];
    LAS unsigned char* lds = (LAS unsigned char*)lds_raw;
    volatile LAS unsigned* MISC = (volatile LAS unsigned*)(lds + MISC_OFF);
    const int tid = threadIdx.x, lane = tid & 63, wave = __builtin_amdgcn_readfirstlane(tid >> 6);
    const int G = gridDim.x, bx = blockIdx.x;
    const int gw = bx * NWAVES + wave, NGW = G * NWAVES;
    unsigned char* ws = args.ws; float* out = args.out;
    for (int u = tid; u < (LDS_BYTES - LDSCTL_OFF) / 4; u += NWAVES * 64) ((LAS unsigned*)(lds + LDSCTL_OFF))[u] = 0u;
    __syncthreads();
    XcdBarrier bar; bar.bar = g_bar; bar.x = 0; bar.st = nullptr;
    if (N_LAUNCHES == 1) bar = xcd_barrier_post(g_bar, MISC + 8);
    const int lo = args.ph_lo, hi = args.ph_hi;
#define IN(k) (lo <= (k) && (k) < hi)
#define SEAM(k) do { if (N_LAUNCHES == 1 && IN(k) && IN((k) + 1)) xcd_barrier(bar); } while (0)

    const float* x_p = args.in[0]; const float* x_s = args.in[1]; const float* cache_k = args.in[2]; const float* cache_v = args.in[3]; const float* cache_ckv = args.in[4]; const float* cache_kr = args.in[5];
    float* TAB = (float*)(ws + WS_TAB);
    bf16_t* W1I = (bf16_t*)(ws + WS_W1I); bf16_t* W1O = (bf16_t*)(ws + WS_W1O); bf16_t* WIN = (bf16_t*)(ws + WS_WIN); bf16_t* WUQ = (bf16_t*)(ws + WS_WUQ); bf16_t* WKV = (bf16_t*)(ws + WS_WKV);
    bf16_t* WBS = (bf16_t*)(ws + WS_WBS); bf16_t* WBM = (bf16_t*)(ws + WS_WBM); bf16_t* WO = (bf16_t*)(ws + WS_WO); bf16_t* W2I = (bf16_t*)(ws + WS_W2I); bf16_t* W2O = (bf16_t*)(ws + WS_W2O);
    bf16_t* HB = (bf16_t*)(ws + WS_HB); bf16_t* ACT = (bf16_t*)(ws + WS_ACT); bf16_t* Y = (bf16_t*)(ws + WS_Y); float* H = (float*)(ws + WS_H);
    bf16_t* QS = (bf16_t*)(ws + WS_QS); float* CQ = (float*)(ws + WS_CQ); float* CKV = (float*)(ws + WS_CKV); float* KR = (float*)(ws + WS_KR); bf16_t* Gt = (bf16_t*)(ws + WS_G);
    bf16_t* CKA = (bf16_t*)(ws + WS_CKA); bf16_t* CQB = (bf16_t*)(ws + WS_CQB); bf16_t* QM = (bf16_t*)(ws + WS_QM); bf16_t* KN = (bf16_t*)(ws + WS_KN); bf16_t* VT = (bf16_t*)(ws + WS_VT);
    float* SLAB = (float*)(ws + WS_CQ);
    bf16_t* KRB = (bf16_t*)(ws + WS_KRB);
    bf16_t* OSB = (bf16_t*)(ws + WS_OSB); bf16_t* OML = (bf16_t*)(ws + WS_OML); float* T = (float*)(ws + WS_T); bf16_t* MG = (bf16_t*)(ws + WS_MG);

    if (IN(0)) {
        LAS float* scr = (LAS float*)(lds + wave * 16384);
        transpose_matrix<1>(args.in[6], DM, 2 * FF, W1I, scr, gw, NGW, lane);
        { u32x4* z = (u32x4*)(WIN + (size_t)8256 * DM); const u32x4 zero = {0u, 0u, 0u, 0u};
          for (int i = bx * (NWAVES * 64) + tid; i < (NIN - 8256) * DM / 8; i += G * NWAVES * 64) z[i] = zero; }
        for (int m = gw; m < MTOK; m += NGW) { const float* xr = (m < NPROMPT ? x_p + (size_t)m * DM : x_s + (size_t)(m - NPROMPT) * DM) + lane * 8; bf16_t* xo = HB + (size_t)m * DM + lane * 8;
#pragma unroll
            for (int j = 0; j < 4; ++j) *(u32x4*)(xo + j * 512) = pk8(*(const f32x4*)(xr + j * 512), *(const f32x4*)(xr + j * 512 + 4)); }
        for (int i = bx * (NWAVES * 64) + tid; i < SEQ * 32; i += G * NWAVES * 64) { const int pos = i >> 5, fi = i & 31; const float inv = powf(10000.f, -(float)(2 * fi) / 64.f); const float ang = (float)pos * inv;
            TAB[2 * i] = cosf(ang); TAB[2 * i + 1] = sinf(ang); }
    }
    SEAM(0);
    if (IN(1)) { pg8::Gemm g{HB, W1I, MTOK, 2 * FF, DM}; pg8::StaticOrder S; S.init(MTOK, 2 * FF, G, bx, g.K); pg8::EpiSwiGLU E{ACT, FF};
        pg8::gemm_phase<pg8::EpiSwiGLU, pg8::StaticOrder, true, true>(lds, g, S, E);
        constexpr int R1 = (MTOK / 256) * (2 * FF / 256) % 256;
        if (G == 256 ? bx >= R1 : true) { const int fw = (G == 256 ? (bx - R1) : bx) * NWAVES + wave, FNW = (G == 256 ? (256 - R1) : G) * NWAVES; LAS float* scr = (LAS float*)(lds + wave * 16384);
            transpose_matrix<0>(args.in[7], FF, DM, W1O, scr, fw, FNW, lane);
            transpose_matrix<2>(args.in[10], DM, 8256, WIN, scr, fw, FNW, lane);
            transpose_matrix<3>(args.in[15], 512, 2048, WKV, scr, fw, FNW, lane);
        { const float* Wuq = args.in[13];
          for (int rho = fw; rho < 1536; rho += FNW) { const int hh = rho / 192, j = rho - hh * 192; const int src = j < 128 ? rho : hh * 192 + 128 + (((j - 128) & 1) ? 32 + ((j - 128) >> 1) : ((j - 128) >> 1));
              const float* wp = Wuq + src + (size_t)(lane * 8) * 1536; f32x4 a, c;
#pragma unroll
              for (int e = 0; e < 4; ++e) { a[e] = wp[(size_t)e * 1536]; c[e] = wp[(size_t)(4 + e) * 1536]; }
              *(u32x4*)(WUQ + (size_t)rho * 512 + lane * 8) = pk8(a, c); } }
        } }
    SEAM(1);
    if (IN(2)) { pg8::Gemm g{ACT, W1O, MTOK, DM, FF}; pg8::SplitOrder S; S.init(DM, G, bx, g.K); pg8::EpiResid E{x_p, x_s, Y, ALPHA, 0.5f, SLAB};
        pg8::gemm_phase<pg8::EpiResid, pg8::SplitOrder, true, true>(lds, g, S, E); }
    SEAM(2);
    if (IN(3)) ln_phase<pg8::split_nch(FF), false>(lds, Y, args.in[8], args.in[9], nullptr, nullptr, HB, SLAB, x_s, ALPHA, 0.5f, bx, G, tid, wave, lane);
    SEAM(3);
    if (IN(4)) { pg8::Gemm g{HB, WIN, MTOK, NIN, DM}; pg8::StaticOrder S; S.init(MTOK, NIN, G, bx, g.K);
        pg8::EpiWin E{QS, out, CQ, KR, Gt, args.in[11], SBQ_SCALE};
        pg8::gemm_phase<pg8::EpiWin, pg8::StaticOrder, true, true>(lds, g, S, E);
        constexpr int R4 = (MTOK / 256) * (NIN / 256) % 256;
        if (G == 256 ? bx >= R4 : true) { const int fw = (G == 256 ? (bx - R4) : bx) * NWAVES + wave, FNW = (G == 256 ? (256 - R4) : G) * NWAVES; LAS float* scr = (LAS float*)(lds + wave * 16384);
            transpose_matrix<0>(args.in[16], 1024, DM, WBS, scr, fw, FNW, lane);
            transpose_matrix<0>(args.in[17], 1024, DM, WBM, scr, fw, FNW, lane);
            transpose_matrix<0>(args.in[18], DM, DM, WO, scr, fw, FNW, lane);
            transpose_matrix<1>(args.in[21], DM, 2 * FF, W2I, scr, fw, FNW, lane);
            transpose_matrix<0>(args.in[22], FF, DM, W2O, scr, fw, FNW, lane);
        } }
    SEAM(4);
    if (IN(5)) {
        const float* gcq = args.in[12]; const float* gckv = args.in[14];
        for (int m = gw; m < MTOK; m += NGW) {
            { const float* p = CQ + (size_t)m * 512 + lane * 8; const f32x4 a = *(const f32x4*)p, c = *(const f32x4*)(p + 4);
              const float ss = wave_sum((a[0] * a[0] + a[1] * a[1]) + (a[2] * a[2] + a[3] * a[3]) + (c[0] * c[0] + c[1] * c[1]) + (c[2] * c[2] + c[3] * c[3]));
              const float rs = 1.f / sqrtf(ss * (1.f / 512.f) + RMS_EPS); const f32x4 g0 = *(const f32x4*)(gcq + lane * 8), g1 = *(const f32x4*)(gcq + lane * 8 + 4);
              *(u32x4*)(CQB + (size_t)m * 512 + lane * 8) = pk8(a * rs * g0, c * rs * g1); }
            { const float* p = CKV + (size_t)m * 512 + lane * 8; const f32x4 a = *(const f32x4*)p, c = *(const f32x4*)(p + 4);
              const float ss = wave_sum((a[0] * a[0] + a[1] * a[1]) + (a[2] * a[2] + a[3] * a[3]) + (c[0] * c[0] + c[1] * c[1]) + (c[2] * c[2] + c[3] * c[3]));
              const float rs = 1.f / sqrtf(ss * (1.f / 512.f) + RMS_EPS); const f32x4 g0 = *(const f32x4*)(gckv + lane * 8), g1 = *(const f32x4*)(gckv + lane * 8 + 4);
              const f32x4 y0 = a * rs * g0, y1 = c * rs * g1;
              float* po = (m < NPROMPT ? out + O_CKVP + (size_t)m * 512 : out + O_CKVS + (size_t)(m - NPROMPT) * 512) + lane * 8; *(f32x4*)po = y0; *(f32x4*)(po + 4) = y1;
              *(u32x4*)(CKA + (size_t)tok_krow(m) * 512 + lane * 8) = pk8(y0, y1); }
            if (lane < 32) { const float x1 = KR[(size_t)m * 64 + lane], x2 = KR[(size_t)m * 64 + 32 + lane]; const int pos = tok_pos(m); const float cs = TAB[(size_t)pos * 64 + 2 * lane], sn = TAB[(size_t)pos * 64 + 2 * lane + 1];
              float* po = (m < NPROMPT ? out + O_KRP + (size_t)m * 64 : out + O_KRS + (size_t)(m - NPROMPT) * 64); const float o1 = x1 * cs - x2 * sn, o2 = x2 * cs + x1 * sn; po[lane] = o1; po[32 + lane] = o2; if (m < NPROMPT) ((unsigned*)KRB)[(size_t)m * 32 + lane] = pk2(o1, o2); }
        }
        for (int rr = gw; rr < DEC_B * PAST; rr += NGW) { const int b = rr >> 10, key = rr & (PAST - 1); const float* p = cache_ckv + (size_t)rr * 512 + lane * 8;
            *(u32x4*)(CKA + (size_t)(NPROMPT + b * KEYS_S + key) * 512 + lane * 8) = pk8(*(const f32x4*)p, *(const f32x4*)(p + 4)); }
        for (int i = bx * (NWAVES * 64) + tid; i < 1024 * 8; i += G * NWAVES * 64) { const u32x4 zero = {0u, 0u, 0u, 0u}; *(u32x4*)(VT + (size_t)(i >> 3) * VPITCH + KROWS + (i & 7) * 8) = zero; }
    }
    SEAM(5);
    if (IN(6)) {
        { pg8::Gemm g{CQB, WUQ, MTOK, 1536, 512}; pg8::StaticOrder S; S.init(MTOK, 1536, G, bx, g.K); pg8::EpiUq E{QM, TAB, MLAQ_SCALE};
          pg8::gemm_phase<pg8::EpiUq, pg8::StaticOrder, true, true>(lds, g, S, E); }
        { pg8::Gemm g{CKA, WKV, KROWS, 1024, 512}; pg8::StaticOrder S; S.init(KROWS, 1024, G, bx, g.K); pg8::EpiPlain E{KN, 1024};
          pg8::gemm_phase<pg8::EpiPlain, pg8::StaticOrder, true, true>(lds, g, S, E); }
        { pg8::Gemm g{WKV + (size_t)1024 * 512, CKA, 1024, KROWS, 512}; pg8::StaticOrder S; S.init(1024, KROWS, G, bx, g.K); pg8::EpiPlain E{VT, VPITCH};
          pg8::gemm_phase<pg8::EpiPlain, pg8::StaticOrder, true, true>(lds, g, S, E); }
        for (int u = bx; u < 2 * 8 * (SEQ / 256); u += G) sb_prompt_unit(lds, u >> 7, (u >> 4) & 7, u & 15, QS, out + O_KP, out + O_VP, OSB, tid, lane, wave);
        for (int u = (G == 256 ? bx - 128 : bx); u >= 0 && u < DEC_B * 8; u += G) sb_sample_unit(lds, u >> 3, u & 7, QS, cache_k, cache_v, out + O_KS, out + O_VS, OSB, lane, wave);
    }
    SEAM(6);
    if (IN(7)) {
        { const int bh = (bx >> 4) & 15, j = bx & 15;
          for (int c0 = bx; c0 < 256; c0 += G) { const int c = (G == 256) ? ((c0 & 7) * 32 + (c0 >> 3)) : c0;
              const int bh2 = c >> 4, j2 = c & 15;
              mla_prompt_unit(lds, bh2 >> 3, bh2 & 7, 31 - j2, QM, KN, VT, KRB, OML, tid, lane, wave);
              mla_prompt_unit(lds, bh2 >> 3, bh2 & 7, j2, QM, KN, VT, KRB, OML, tid, lane, wave); }
          (void)bh; (void)j; }
        for (int u = bx; u < DEC_B * 8; u += G) mla_sample_unit(lds, u >> 3, u & 7, QM, KN, VT, cache_kr, out + O_KRS, OML, lane, wave);
    }
    SEAM(7);
    if (IN(8)) {
        float* SL8 = (float*)(ws + WS_KN);
        { pg8::Gemm g{OSB, WBS, MTOK, DM, 1024}; pg8::SplitOrder S; S.init(DM, G, bx, g.K, 0); pg8::EpiBrSb E{T, Gt, SL8};
          pg8::gemm_phase<pg8::EpiBrSb, pg8::SplitOrder, true, true>(lds, g, S, E); }
        { pg8::Gemm g{OML, WBM, MTOK, DM, 1024}; pg8::SplitOrder S; S.init(DM, G, bx, g.K, 64); pg8::EpiBrMla E{T, Gt, MG, SL8 + (size_t)8 * NSAMPLE * DM};
          pg8::gemm_phase<pg8::EpiBrMla, pg8::SplitOrder, true, true>(lds, g, S, E); }
    }
    SEAM(8);
    if (IN(9)) {
        const f32x4* SL8 = (const f32x4*)(ws + WS_KN);
        for (int sr = bx; sr < NSAMPLE; sr += G) {
            const f32x4* sp = SL8 + (size_t)sr * (DM / 4) + tid; f32x4 a = sp[0], c = sp[(size_t)8 * (NSAMPLE * DM / 4)];
#pragma unroll
            for (int k = 1; k < 8; ++k) { a += sp[(size_t)k * (NSAMPLE * DM / 4)]; c += sp[(size_t)(8 + k) * (NSAMPLE * DM / 4)]; }
            const bf16_t* gp = Gt + (size_t)(NPROMPT + sr) * 4096 + tid * 4; const u32x2 gs = *(const u32x2*)gp, gm = *(const u32x2*)(gp + 2048);
            const f32x4 g0 = {pg8::bf_lo(gs.x), pg8::bf_hi(gs.x), pg8::bf_lo(gs.y), pg8::bf_hi(gs.y)}, g1 = {pg8::bf_lo(gm.x), pg8::bf_hi(gm.x), pg8::bf_lo(gm.y), pg8::bf_hi(gm.y)};
            const f32x4 o = g0 * a + g1 * c; u32x2 w; w.x = pk2(o[0], o[1]); w.y = pk2(o[2], o[3]);
            *(u32x2*)(MG + (size_t)(NPROMPT + sr) * DM + tid * 4) = w; }
    }
    SEAM(9);
    if (IN(10)) { pg8::Gemm g{MG, WO, MTOK, DM, DM}; pg8::SplitOrder S; S.init(DM, G, bx, g.K); pg8::EpiResidB E{HB, Y, ALPHA, 1.f, SLAB};
        pg8::gemm_phase<pg8::EpiResidB, pg8::SplitOrder, true, true>(lds, g, S, E); }
    SEAM(10);
    if (IN(11)) ln_phase<pg8::split_nch(DM), true>(lds, Y, args.in[19], args.in[20], nullptr, nullptr, HB, SLAB, HB + (size_t)NPROMPT * DM, ALPHA, 1.f, bx, G, tid, wave, lane);
    SEAM(11);
    if (IN(12)) { pg8::Gemm g{HB, W2I, MTOK, 2 * FF, DM}; pg8::StaticOrder S; S.init(MTOK, 2 * FF, G, bx, g.K); pg8::EpiSwiGLU E{ACT, FF};
        pg8::gemm_phase<pg8::EpiSwiGLU, pg8::StaticOrder, true, true>(lds, g, S, E); }
    SEAM(12);
    if (IN(13)) { pg8::Gemm g{ACT, W2O, MTOK, DM, FF}; pg8::SplitOrder S; S.init(DM, G, bx, g.K); pg8::EpiResidB E{HB, Y, ALPHA, 0.5f, SLAB};
        pg8::gemm_phase<pg8::EpiResidB, pg8::SplitOrder, true, true>(lds, g, S, E); }
    SEAM(13);
    if (IN(14)) ln_phase<pg8::split_nch(FF), true>(lds, Y, args.in[23], args.in[24], out + O_YP, out + O_YS, nullptr, SLAB, HB + (size_t)NPROMPT * DM, ALPHA, 0.5f, bx, G, tid, wave, lane);
#undef IN
#undef SEAM
    if (N_LAUNCHES == 1) {
        __syncthreads();
        if (tid == 0) MISC[12] = (xb_add(&g_bar[GB_DONE], 1u) == (unsigned)G - 1u) ? 1u : 0u;
        __syncthreads();
        if (MISC[12]) { for (int i = tid; i < XCD_BAR_WORDS + 64; i += NWAVES * 64) __hip_atomic_store(&g_bar[i], 0u, __ATOMIC_RELAXED, __HIP_MEMORY_SCOPE_AGENT); }
    }
}

extern "C" void kernel_launch(void* const* d_in, const int* in_sizes, int n_in, void* d_out, int out_size, void* d_ws, size_t ws_size, hipStream_t stream) {
    static int grid = 0;
    if (grid == 0) {
        if (n_in != 25 || out_size != (int)O_END || ws_size < WS_END) { fprintf(stderr, "kernel_launch: expected 25 inputs, %zu outputs, >= %zu B workspace; got %d, %d, %zu\n", (size_t)O_END, (size_t)WS_END, n_in, out_size, ws_size); grid = -1; return; }
        int dev = 0, cus = 0, per_cu = 0;
        if (hipGetDevice(&dev) != hipSuccess || hipDeviceGetAttribute(&cus, hipDeviceAttributeMultiprocessorCount, dev) != hipSuccess) { grid = -1; return; }
        if (hipFuncSetAttribute((const void*)fwd_kernel, hipFuncAttributeMaxDynamicSharedMemorySize, LDS_BYTES) != hipSuccess) { fprintf(stderr, "kernel_launch: hipFuncSetAttribute failed\n"); grid = -1; return; }
        if (hipOccupancyMaxActiveBlocksPerMultiprocessor(&per_cu, (const void*)fwd_kernel, NWAVES * 64, LDS_BYTES) != hipSuccess || per_cu < 1) fprintf(stderr, "kernel_launch: occupancy query says %d\n", per_cu);
        (void)hipGetLastError();
        grid = cus;
        if (grid != 256) { fprintf(stderr, "kernel_launch: built for a 256-CU device (the split-K order deals exactly 256 prompt tiles), found %d CUs; nothing launched\n", cus); grid = -1; return; }
    }
    if (grid < 0) return;
    Args a{};
    for (int i = 0; i < 25; ++i) a.in[i] = (const float*)d_in[i];
    a.out = (float*)d_out; a.ws = (unsigned char*)d_ws;
    for (int li = 0; li < N_LAUNCHES; ++li) {
        a.ph_lo = (N_LAUNCHES == 1) ? 0 : li; a.ph_hi = (N_LAUNCHES == 1) ? NPHASE : li + 1;
        hipLaunchKernelGGL(fwd_kernel, dim3(grid), dim3(NWAVES * 64), LDS_BYTES, stream, a);
        const hipError_t le = hipPeekAtLastError();
        if (le != hipSuccess) { fprintf(stderr, "kernel_launch: launch %d failed: %s\n", li, hipGetErrorName(le)); break; }
    }
}
```

```cpp
#include <hip/hip_runtime.h>
#include <cstdio>
#include <cstdint>
#include <cmath>
constexpr int DM = 2048, NPROMPT = 8192, NSAMPLE = 256, MTOK = NPROMPT + NSAMPLE;
constexpr int SEQ = 4096, DEC_B = 16, DEC_T = 16, PAST = 1024, KEYS_S = PAST + DEC_T;
constexpr int FF = 5504, NIN = 8448;
constexpr int KROWS = NPROMPT + DEC_B * KEYS_S;
constexpr int VPITCH = KROWS + 64;
constexpr float LN_EPS = 1e-5f, RMS_EPS = 1e-6f;
constexpr float ALPHA = 1.18920711500272f;
constexpr float LOG2E = 1.4426950408889634f;
constexpr float SBQ_SCALE = 0.08838834764831845f * LOG2E;
constexpr float MLAQ_SCALE = 0.07216878364870323f * LOG2E;
namespace pg8 {
#define PG8_LAS __attribute__((address_space(3)))
typedef unsigned short bf16_t;
typedef short bf16x8 __attribute__((ext_vector_type(8)));
typedef float f32x4 __attribute__((ext_vector_type(4)));
typedef unsigned u32x4 __attribute__((ext_vector_type(4)));
constexpr int BM = 256, BK = 64, HALF = 128, HTB = HALF * BK * 2  , STAGE_BYTES = 8 * HTB, NXCD = 8, WGM = 8;

__host__ __device__ __forceinline__ int lds_byte(int r, int c) { const int st = (r >> 4) * 2 + (c >> 5), rr = r & 15, cc = c & 31, ob = rr * 64 + cc * 2; return st * 1024 + (ob ^ (((ob >> 9) & 1) << 5)); }
__host__ __device__ __forceinline__ void stage_rc(int b, int& R, int& C) { const int st = b / 1024, sb = b % 1024, swz = sb ^ (((sb >> 9) & 1) << 5); R = (st >> 1) * 16 + swz / 64; C = (st & 1) * 32 + (swz % 64) / 2; }
__host__ __device__ __forceinline__ int perm32(int rho) { const int n = rho >> 4, i = rho & 15; return 8 * (i >> 2) + 4 * n + (i & 3); }

struct Unit { int pm, pn, kofs, nt, chunk; };
struct Gemm { const bf16_t* A; const bf16_t* Bt; int M, N, K; };

struct StaticOrder {
    int nM, nN, nwg, G, c, ntf;
    __host__ __device__ void init(int M, int N, int G_, int c_, int K_) { nM = M / BM; nN = N / BM; nwg = nM * nN; G = G_; c = c_; ntf = K_ / BK; }
    __host__ __device__ bool next(int i, Unit& u) const {
        const long L = (long)i * G + c; if (L >= nwg) return false;
        int wgid = (int)L; { const int q = nwg / NXCD, r = nwg % NXCD, xcd = wgid % NXCD, off = wgid / NXCD; wgid = (xcd < r ? xcd * (q + 1) : r * (q + 1) + (xcd - r) * q) + off; }
        const int nig = WGM * nN, gid = wgid / nig, fm = gid * WGM, gsz = (nM - fm) < WGM ? (nM - fm) : WGM;
        u.pm = fm + ((wgid % nig) % gsz); u.pn = (wgid % nig) / gsz; u.kofs = 0; u.nt = ntf; u.chunk = -1; return true;
    }
    __device__ __forceinline__ void a_ready(const Unit&) const {}
    __device__ __forceinline__ void done(const Unit&) const {}
};

struct SplitOrder {
    StaticOrder P; int nch, base, extra, c;
    __host__ __device__ void init(int N, int G_, int c_, int K_, int coff = 0) { P.init(NPROMPT, N, G_, c_, K_); const int np = K_ / (2 * BK); nch = np < 16 ? np : 16; base = np / nch; extra = np % nch; c = c_ - coff; }
    __host__ __device__ bool next(int i, Unit& u) const {
        if (i == 0) return P.next(0, u);
        if (i > 1 || c < 0 || c >= 8 * nch) return false;
        const int j = c >> 3; u.pm = NPROMPT / BM; u.pn = c & 7; u.chunk = j; u.nt = 2 * (base + (j < extra ? 1 : 0)); u.kofs = 2 * BK * (j * base + (j < extra ? j : extra)); return true;
    }
    __device__ __forceinline__ void a_ready(const Unit&) const {}
    __device__ __forceinline__ void done(const Unit&) const {}
};
constexpr int split_nch(int K_) { return (K_ / 128) < 16 ? (K_ / 128) : 16; }

__device__ __forceinline__ unsigned cvt_pk_bf16(float lo, float hi) { unsigned r; asm volatile("v_cvt_pk_bf16_f32 %0, %1, %2" : "=v"(r) : "v"(lo), "v"(hi)); return r; }
typedef float f32x2 __attribute__((ext_vector_type(2)));
typedef float f32x2_t __attribute__((ext_vector_type(2))); typedef __bf16 bf16x2_t __attribute__((ext_vector_type(2)));
__device__ __forceinline__ unsigned pk2(float lo, float hi) { f32x2_t v = {lo, hi}; bf16x2_t b = __builtin_convertvector(v, bf16x2_t); return __builtin_bit_cast(unsigned, b); }
__device__ __forceinline__ u32x4 pk8(const f32x4 a, const f32x4 b) { u32x4 w; w.x = pk2(a[0], a[1]); w.y = pk2(a[2], a[3]); w.z = pk2(b[0], b[1]); w.w = pk2(b[2], b[3]); return w; }
__device__ __forceinline__ float bf_lo(unsigned w) { return __builtin_bit_cast(float, w << 16); }
__device__ __forceinline__ float bf_hi(unsigned w) { return __builtin_bit_cast(float, w & 0xffff0000u); }
__device__ __forceinline__ void unpk8(const u32x4 w, f32x4& a, f32x4& b) { a = (f32x4){bf_lo(w.x), bf_hi(w.x), bf_lo(w.y), bf_hi(w.y)}; b = (f32x4){bf_lo(w.z), bf_hi(w.z), bf_lo(w.w), bf_hi(w.w)}; }
__device__ __forceinline__ float silu_f(float x) { return x * __builtin_amdgcn_rcpf(1.f + __builtin_amdgcn_exp2f(-1.4426950408889634f * x)); }
__device__ __forceinline__ float sigmoid_f(float x) { return __builtin_amdgcn_rcpf(1.f + __builtin_amdgcn_exp2f(-1.4426950408889634f * x)); }

#define EPI_LOOP_AM _Pragma("unroll") for (int ai = 0; ai < 2; ++ai) _Pragma("unroll") for (int m = 0; m < 4; ++m)

struct EpiSwiGLU {
    static constexpr bool PERM = true, AFTER_DRAIN = false;
    bf16_t* O; int ldc;
    __device__ __forceinline__ void operator()(const f32x4 (&acc)[2][2][4][2], const Unit& u, int wr, int wc, int fr, int fq) const {
        const int row0 = u.pm * BM + wr * 64 + fr, col0 = u.pn * 128 + wc * 32 + 8 * fq;
        EPI_LOOP_AM { bf16_t* p = O + (size_t)(row0 + ai * HALF + m * 16) * ldc + col0;
            f32x4 a, b;
#pragma unroll
            for (int e = 0; e < 4; ++e) { a[e] = silu_f(acc[ai][0][m][0][e]) * acc[ai][1][m][0][e]; b[e] = silu_f(acc[ai][0][m][1][e]) * acc[ai][1][m][1][e]; }
            *(u32x4*)p = pk8(a, b); }
    }
};
struct EpiPlain {
    static constexpr bool PERM = true, AFTER_DRAIN = false;
    bf16_t* O; int ldc;
    __device__ __forceinline__ void operator()(const f32x4 (&acc)[2][2][4][2], const Unit& u, int wr, int wc, int fr, int fq) const {
        const int row0 = u.pm * BM + wr * 64 + fr, col0 = u.pn * BM + wc * 32 + 8 * fq;
        EPI_LOOP_AM { bf16_t* p = O + (size_t)(row0 + ai * HALF + m * 16) * ldc + col0;
#pragma unroll
            for (int bj = 0; bj < 2; ++bj) *(u32x4*)(p + bj * HALF) = pk8(acc[ai][bj][m][0], acc[ai][bj][m][1]); }
    }
};
struct EpiResid {
    static constexpr bool PERM = true, AFTER_DRAIN = false;
    const float* R0; const float* R1; bf16_t* Y; float alpha, s; bf16_t* slab;
    __device__ __forceinline__ void operator()(const f32x4 (&acc)[2][2][4][2], const Unit& u, int wr, int wc, int fr, int fq) const {
        const int row0 = u.pm * BM + wr * 64 + fr, col0 = u.pn * BM + wc * 32 + 8 * fq;
        const bool part = u.chunk >= 0;
        const float al = part ? 0.f : alpha, sc = part ? 1.f : s;
        const float* Rb = (u.pm < NPROMPT / BM) ? R0 + (size_t)row0 * DM : R1 + (size_t)(row0 - NPROMPT) * DM;
        bf16_t* Yb = part ? slab + ((size_t)u.chunk * NSAMPLE + (row0 - NPROMPT)) * DM : Y + (size_t)row0 * DM;
#pragma unroll
        for (int ai = 0; ai < 2; ++ai) {
            f32x4 rv[4][2][2];
#pragma unroll
            for (int m = 0; m < 4; ++m)
#pragma unroll
                for (int bj = 0; bj < 2; ++bj) { const float* rp = Rb + (size_t)(ai * HALF + m * 16) * DM + col0 + bj * HALF; rv[m][bj][0] = *(const f32x4*)rp; rv[m][bj][1] = *(const f32x4*)(rp + 4); }
#pragma unroll
            for (int m = 0; m < 4; ++m)
#pragma unroll
                for (int bj = 0; bj < 2; ++bj) { const size_t ro = (size_t)(ai * HALF + m * 16) * DM + col0 + bj * HALF;
                    const f32x4 y0 = rv[m][bj][0] * al + acc[ai][bj][m][0] * sc, y1 = rv[m][bj][1] * al + acc[ai][bj][m][1] * sc;
                    *(u32x4*)(Yb + ro) = pk8(y0, y1); }
        }
    }
};
struct EpiResidB {
    static constexpr bool PERM = true, AFTER_DRAIN = false;
    const bf16_t* RB; bf16_t* Y; float alpha, s; bf16_t* slab;
    __device__ __forceinline__ void operator()(const f32x4 (&acc)[2][2][4][2], const Unit& u, int wr, int wc, int fr, int fq) const {
        const int row0 = u.pm * BM + wr * 64 + fr, col0 = u.pn * BM + wc * 32 + 8 * fq;
        const bool part = u.chunk >= 0;
        const float al = part ? 0.f : alpha, sc = part ? 1.f : s;
        const bf16_t* Rb = RB + (size_t)row0 * DM;
        bf16_t* Yb = part ? slab + ((size_t)u.chunk * NSAMPLE + (row0 - NPROMPT)) * DM : Y + (size_t)row0 * DM;
#pragma unroll
        for (int ai = 0; ai < 2; ++ai) {
            u32x4 rv[4][2];
#pragma unroll
            for (int m = 0; m < 4; ++m)
#pragma unroll
                for (int bj = 0; bj < 2; ++bj) rv[m][bj] = *(const u32x4*)(Rb + (size_t)(ai * HALF + m * 16) * DM + col0 + bj * HALF);
#pragma unroll
            for (int m = 0; m < 4; ++m)
#pragma unroll
                for (int bj = 0; bj < 2; ++bj) { const size_t ro = (size_t)(ai * HALF + m * 16) * DM + col0 + bj * HALF; f32x4 r0, r1; unpk8(rv[m][bj], r0, r1);
                    const f32x4 y0 = r0 * al + acc[ai][bj][m][0] * sc, y1 = r1 * al + acc[ai][bj][m][1] * sc;
                    *(u32x4*)(Yb + ro) = pk8(y0, y1); }
        }
    }
};
struct EpiWin {
    static constexpr bool PERM = true, AFTER_DRAIN = false;
    bf16_t* QS; float* out; float* CQ; float* KR; bf16_t* G; const float* bgate; float qscale;
    __device__ __forceinline__ void operator()(const f32x4 (&acc)[2][2][4][2], const Unit& u, int wr, int wc, int fr, int fq) const {
        const int row0 = u.pm * BM + wr * 64 + fr, colt = wc * 32 + 8 * fq; const int pn = u.pn;
        if (pn < 4) {
            EPI_LOOP_AM { bf16_t* p = QS + (size_t)(row0 + ai * HALF + m * 16) * 1024 + pn * BM + colt;
#pragma unroll
                for (int bj = 0; bj < 2; ++bj) *(u32x4*)(p + bj * HALF) = pk8(acc[ai][bj][m][0] * qscale, acc[ai][bj][m][1] * qscale); }
        } else if (pn < 12) {
            const bool isk = pn < 8; const bool smp = u.pm >= NPROMPT / BM;
            size_t off = isk ? (size_t)17301504 : (size_t)25690112;
            if (smp) off = isk ? (size_t)38797312 : (size_t)39059456;
            const int rr = smp ? row0 - NPROMPT : row0; const int cc = (pn - (isk ? 4 : 8)) * BM + colt;
            EPI_LOOP_AM { float* p = out + off + (size_t)(rr + ai * HALF + m * 16) * 1024 + cc;
#pragma unroll
                for (int bj = 0; bj < 2; ++bj) { *(f32x4*)(p + bj * HALF) = acc[ai][bj][m][0]; *(f32x4*)(p + bj * HALF + 4) = acc[ai][bj][m][1]; } }
        } else if (pn < 16) {
            const size_t off = (pn < 14 ? (size_t)0 : (size_t)MTOK * 512); const int cc = (pn & 1) * BM + colt;
            EPI_LOOP_AM { float* p = CQ + off + (size_t)(row0 + ai * HALF + m * 16) * 512 + cc;
#pragma unroll
                for (int bj = 0; bj < 2; ++bj) { *(f32x4*)(p + bj * HALF) = acc[ai][bj][m][0]; *(f32x4*)(p + bj * HALF + 4) = acc[ai][bj][m][1]; } }
        } else if (pn < 32) {
            const int cc = (pn - 16) * BM + colt;
            f32x4 bg[2][2];
#pragma unroll
            for (int bj = 0; bj < 2; ++bj) { bg[bj][0] = *(const f32x4*)(bgate + cc + bj * HALF); bg[bj][1] = *(const f32x4*)(bgate + cc + bj * HALF + 4); }
            EPI_LOOP_AM { bf16_t* p = G + (size_t)(row0 + ai * HALF + m * 16) * 4096 + cc;
#pragma unroll
                for (int bj = 0; bj < 2; ++bj) { f32x4 a = acc[ai][bj][m][0] + bg[bj][0], b = acc[ai][bj][m][1] + bg[bj][1];
#pragma unroll
                    for (int e = 0; e < 4; ++e) { a[e] = sigmoid_f(a[e]); b[e] = sigmoid_f(b[e]); }
                    *(u32x4*)(p + bj * HALF) = pk8(a, b); } }
        } else {
            if (wc < 2) { EPI_LOOP_AM { float* p = KR + (size_t)(row0 + ai * HALF + m * 16) * 64 + colt; *(f32x4*)p = acc[ai][0][m][0]; *(f32x4*)(p + 4) = acc[ai][0][m][1]; } }
        }
    }
};
struct EpiUq {
    static constexpr bool PERM = true, AFTER_DRAIN = false;
    bf16_t* QM; const float* tab; float scale;
    __device__ __forceinline__ void operator()(const f32x4 (&acc)[2][2][4][2], const Unit& u, int wr, int wc, int fr, int fq) const {
        const int row0 = u.pm * BM + wr * 64 + fr, col0 = u.pn * BM + wc * 32 + 8 * fq;
        EPI_LOOP_AM { const int row = row0 + ai * HALF + m * 16; const int pos = row < NPROMPT ? (row & 4095) : 1024 + ((row - NPROMPT) & 15);
            bf16_t* p = QM + (size_t)row * 1536 + col0;
#pragma unroll
            for (int bj = 0; bj < 2; ++bj) { const int col = col0 + bj * HALF; const int hc = col % 192; f32x4 a = acc[ai][bj][m][0], b = acc[ai][bj][m][1];
                if (hc >= 128) { const float* t = tab + (size_t)pos * 64 + (hc - 128);
                    const f32x4 t0 = *(const f32x4*)t, t1 = *(const f32x4*)(t + 4);
                    const f32x4 a2 = {a[0] * t0[0] - a[1] * t0[1], a[1] * t0[0] + a[0] * t0[1], a[2] * t0[2] - a[3] * t0[3], a[3] * t0[2] + a[2] * t0[3]};
                    const f32x4 b2 = {b[0] * t1[0] - b[1] * t1[1], b[1] * t1[0] + b[0] * t1[1], b[2] * t1[2] - b[3] * t1[3], b[3] * t1[2] + b[2] * t1[3]};
                    a = a2; b = b2; }
                *(u32x4*)(p + bj * HALF) = pk8(a * scale, b * scale); } }
    }
};
struct EpiBrSb {
    static constexpr bool PERM = true, AFTER_DRAIN = false;
    float* T; const bf16_t* G; bf16_t* slab;
    __device__ __forceinline__ void operator()(const f32x4 (&acc)[2][2][4][2], const Unit& u, int wr, int wc, int fr, int fq) const {
        const int row0 = u.pm * BM + wr * 64 + fr, col0 = u.pn * BM + wc * 32 + 8 * fq; const bool part = u.chunk >= 0;
        if (part) { bf16_t* sp = slab + ((size_t)u.chunk * NSAMPLE + (row0 - NPROMPT)) * DM + col0;
            EPI_LOOP_AM {
#pragma unroll
                for (int bj = 0; bj < 2; ++bj) *(u32x4*)(sp + (size_t)(ai * HALF + m * 16) * DM + bj * HALF) = pk8(acc[ai][bj][m][0], acc[ai][bj][m][1]); }
        } else {
#pragma unroll
        for (int ai = 0; ai < 2; ++ai) {
            u32x4 gv[4][2];
#pragma unroll
            for (int m = 0; m < 4; ++m)
#pragma unroll
                for (int bj = 0; bj < 2; ++bj) gv[m][bj] = *(const u32x4*)(G + (size_t)(row0 + ai * HALF + m * 16) * 4096 + col0 + bj * HALF);
#pragma unroll
            for (int m = 0; m < 4; ++m)
#pragma unroll
                for (int bj = 0; bj < 2; ++bj) { f32x4 g0, g1; unpk8(gv[m][bj], g0, g1);
                    float* tp = T + (size_t)(row0 + ai * HALF + m * 16) * DM + col0 + bj * HALF; *(f32x4*)tp = g0 * acc[ai][bj][m][0]; *(f32x4*)(tp + 4) = g1 * acc[ai][bj][m][1]; }
        } }
    }
};
struct EpiBrMla {
    static constexpr bool PERM = true, AFTER_DRAIN = false;
    const float* T; const bf16_t* G; bf16_t* MG; bf16_t* slab;
    __device__ __forceinline__ void operator()(const f32x4 (&acc)[2][2][4][2], const Unit& u, int wr, int wc, int fr, int fq) const {
        const int row0 = u.pm * BM + wr * 64 + fr, col0 = u.pn * BM + wc * 32 + 8 * fq;
        if (u.chunk >= 0) { bf16_t* sp = slab + ((size_t)u.chunk * NSAMPLE + (row0 - NPROMPT)) * DM + col0;
            EPI_LOOP_AM {
#pragma unroll
                for (int bj = 0; bj < 2; ++bj) *(u32x4*)(sp + (size_t)(ai * HALF + m * 16) * DM + bj * HALF) = pk8(acc[ai][bj][m][0], acc[ai][bj][m][1]); }
        } else {
#pragma unroll
            for (int ai = 0; ai < 2; ++ai)
#pragma unroll
                for (int mh = 0; mh < 2; ++mh) {
                    u32x4 gv[2][2]; f32x4 tv[2][2][2];
#pragma unroll
                    for (int mm = 0; mm < 2; ++mm)
#pragma unroll
                        for (int bj = 0; bj < 2; ++bj) { const int row = row0 + ai * HALF + (2 * mh + mm) * 16; gv[mm][bj] = *(const u32x4*)(G + (size_t)row * 4096 + 2048 + col0 + bj * HALF);
                            const float* tp = T + (size_t)row * DM + col0 + bj * HALF; tv[mm][bj][0] = *(const f32x4*)tp; tv[mm][bj][1] = *(const f32x4*)(tp + 4); }
#pragma unroll
                    for (int mm = 0; mm < 2; ++mm)
#pragma unroll
                        for (int bj = 0; bj < 2; ++bj) { const int m = 2 * mh + mm; f32x4 g0, g1; unpk8(gv[mm][bj], g0, g1);
                            *(u32x4*)(MG + (size_t)(row0 + ai * HALF + m * 16) * DM + col0 + bj * HALF) = pk8(tv[mm][bj][0] + g0 * acc[ai][bj][m][0], tv[mm][bj][1] + g1 * acc[ai][bj][m][1]); }
                }
        }
    }
};
template <class Epi, class Sched, bool ALIGN_EPI = false, bool SP2 = false>
__device__ __forceinline__ void gemm_phase(PG8_LAS unsigned char* lds, const Gemm g, const Sched& S, const Epi& E) {
    const int tid = threadIdx.x, wid = __builtin_amdgcn_readfirstlane(tid >> 6), lane = tid & 63, wr = wid >> 2, wc = wid & 3, fr = lane & 15, fq = lane >> 4;
    const int K = g.K;
    unsigned voffA[2], voffB[2];
#pragma unroll
    for (int i = 0; i < 2; ++i) { int R, C; stage_rc(tid * 16 + i * 8192, R, C); const int Rb = Epi::PERM ? ((R & ~31) + perm32(R & 31)) : R;
        voffA[i] = (unsigned)(R * K + C) * 2u; voffB[i] = (unsigned)(Rb * K + C) * 2u; }
    const size_t kstep = (size_t)(BK * 2);
    const size_t hstep = (size_t)HALF * K * 2;
    const size_t tstep = 2 * hstep;
    const unsigned ldsw = (unsigned)wid * 1024u;
    const int aoff = lds_byte(wr * 64 + fr, fq * 8), boff = lds_byte(wc * 32 + fr, fq * 8);
#define PG8_SA(b, h) (((b) * 2 + (h)) * HTB)
#define PG8_SB(b, h) ((4 + (b) * 2 + (h)) * HTB)
#define PG8_STAGE(bufoff, gbase, voff) do { _Pragma("unroll") for (int _i = 0; _i < 2; ++_i) \
        __builtin_amdgcn_global_load_lds((const unsigned*)((const char*)(gbase) + (voff)[_i]), (PG8_LAS unsigned*)(lds + (bufoff) + ldsw + _i * 8192), 16, 0, 0); } while (0)
#define PG8_LDA(dst, b, h) do { _Pragma("unroll") for (int m = 0; m < 4; ++m) _Pragma("unroll") for (int k = 0; k < 2; ++k) dst[m][k] = *(const PG8_LAS bf16x8*)(lds + PG8_SA(b, h) + aoff + m * 2048 + k * 1024); } while (0)
#define PG8_LDB(dst, b, h) do { _Pragma("unroll") for (int n = 0; n < 2; ++n) _Pragma("unroll") for (int k = 0; k < 2; ++k) dst[n][k] = *(const PG8_LAS bf16x8*)(lds + PG8_SB(b, h) + boff + n * 2048 + k * 1024); } while (0)
#define PG8_MMA(ai, bj, At, Bt) do { __builtin_amdgcn_s_setprio(1); _Pragma("unroll") for (int m = 0; m < 4; ++m) _Pragma("unroll") for (int n = 0; n < 2; ++n) _Pragma("unroll") for (int k = 0; k < 2; ++k) \
        acc[ai][bj][m][n] = __builtin_amdgcn_mfma_f32_16x16x32_bf16(Bt[n][k], At[m][k], acc[ai][bj][m][n], 0, 0, 0); __builtin_amdgcn_s_setprio(0); } while (0)
#define PG8_WAIT_V(n) asm volatile("s_waitcnt vmcnt(" #n ")" ::: "memory")
#define PG8_WAIT_L(n) asm volatile("s_waitcnt lgkmcnt(" #n ")" ::: "memory")
#define PG8_BAR __builtin_amdgcn_s_barrier()
#define PG8_SCHED __builtin_amdgcn_sched_barrier(0)
    Unit cur, nxt; int ui = 0;
    if (!S.next(0, cur)) return;
    f32x4 acc[2][2][4][2];
#pragma unroll
    for (int a = 0; a < 2; ++a)
#pragma unroll
        for (int b = 0; b < 2; ++b)
#pragma unroll
            for (int m = 0; m < 4; ++m)
#pragma unroll
                for (int n = 0; n < 2; ++n) acc[a][b][m][n] = (f32x4){0.f, 0.f, 0.f, 0.f};
    bf16x8 At[4][2], B0[2][2], B1[2][2];
    const char* cA = (const char*)g.A + (size_t)cur.pm * tstep + (size_t)cur.kofs * 2; const char* cB = (const char*)g.Bt + (size_t)cur.pn * tstep + (size_t)cur.kofs * 2;
    S.a_ready(cur);
    if constexpr (SP2) {
        PG8_STAGE(PG8_SB(0, 0), cB, voffB); PG8_STAGE(PG8_SB(0, 1), cB + hstep, voffB); PG8_STAGE(PG8_SA(0, 0), cA, voffA); PG8_STAGE(PG8_SA(0, 1), cA + hstep, voffA);
        if (wr == 1) PG8_BAR;
        PG8_WAIT_V(2); PG8_BAR;
        PG8_STAGE(PG8_SB(1, 0), cB + kstep, voffB); PG8_STAGE(PG8_SA(1, 0), cA + kstep, voffA); PG8_STAGE(PG8_SB(1, 1), cB + hstep + kstep, voffB);
        PG8_WAIT_V(6); PG8_BAR;
    } else {
        PG8_STAGE(PG8_SB(0, 0), cB, voffB); PG8_STAGE(PG8_SA(0, 0), cA, voffA); PG8_STAGE(PG8_SB(0, 1), cB + hstep, voffB); PG8_STAGE(PG8_SA(0, 1), cA + hstep, voffA);
        if (wr == 1) PG8_BAR;
        PG8_WAIT_V(4); PG8_BAR;
        PG8_STAGE(PG8_SB(1, 0), cB + kstep, voffB); PG8_STAGE(PG8_SA(1, 0), cA + kstep, voffA); PG8_STAGE(PG8_SB(1, 1), cB + hstep + kstep, voffB);
        PG8_WAIT_V(6); PG8_BAR;
    }
    for (;;) {
        const bool has_next = S.next(ui + 1, nxt);
        const char* nA = has_next ? (const char*)g.A + (size_t)nxt.pm * tstep + (size_t)nxt.kofs * 2 : cA; const char* nB = has_next ? (const char*)g.Bt + (size_t)nxt.pn * tstep + (size_t)nxt.kofs * 2 : cB;
        const int nt = cur.nt;
        for (int t = 0; t < nt; t += 2) {
            const bool last = (t == nt - 2);
            const char* a1 = cA + (size_t)(t + 1) * kstep;
            const char* a2 = last ? nA : cA + (size_t)(t + 2) * kstep; const char* b2 = last ? nB : cB + (size_t)(t + 2) * kstep;
            const char* a3 = a2 + kstep; const char* b3 = b2 + kstep;
            if (last && has_next) S.a_ready(nxt);
            if constexpr (SP2) {
            PG8_LDB(B0, 0, 0); PG8_LDB(B1, 0, 1); PG8_SCHED; PG8_LDA(At, 0, 0); PG8_STAGE(PG8_SA(1, 1), a1 + hstep, voffA);
            PG8_WAIT_V(8); PG8_WAIT_L(0); PG8_BAR; PG8_MMA(0, 0, At, B0); PG8_MMA(0, 1, At, B1); PG8_BAR; PG8_SCHED;
            PG8_LDA(At, 0, 1); PG8_STAGE(PG8_SB(0, 0), b2, voffB); PG8_STAGE(PG8_SB(0, 1), b2 + hstep, voffB); PG8_STAGE(PG8_SA(0, 0), a2, voffA);
            PG8_WAIT_V(8); PG8_WAIT_L(0); PG8_BAR; PG8_MMA(1, 0, At, B0); PG8_MMA(1, 1, At, B1); PG8_BAR; PG8_SCHED;
            PG8_LDB(B0, 1, 0); PG8_LDB(B1, 1, 1); PG8_SCHED; PG8_LDA(At, 1, 0); PG8_STAGE(PG8_SA(0, 1), a2 + hstep, voffA);
            PG8_WAIT_V(8); PG8_WAIT_L(0); PG8_BAR; PG8_MMA(0, 0, At, B0); PG8_MMA(0, 1, At, B1); PG8_BAR; PG8_SCHED;
            PG8_LDA(At, 1, 1); PG8_STAGE(PG8_SB(1, 0), b3, voffB); PG8_STAGE(PG8_SB(1, 1), b3 + hstep, voffB); PG8_STAGE(PG8_SA(1, 0), a3, voffA);
            PG8_WAIT_V(8); PG8_WAIT_L(0); PG8_BAR; PG8_MMA(1, 0, At, B0); PG8_MMA(1, 1, At, B1); PG8_BAR; PG8_SCHED;
            } else {
            PG8_LDB(B0, 0, 0); PG8_SCHED; PG8_LDA(At, 0, 0); PG8_STAGE(PG8_SA(1, 1), a1 + hstep, voffA);
            PG8_WAIT_L(8); PG8_BAR; PG8_WAIT_L(0); PG8_MMA(0, 0, At, B0); PG8_BAR; PG8_SCHED;
            PG8_LDB(B1, 0, 1); PG8_STAGE(PG8_SB(0, 0), b2, voffB);
            PG8_BAR; PG8_WAIT_L(0); PG8_MMA(0, 1, At, B1); PG8_BAR;
            PG8_LDA(At, 0, 1); PG8_STAGE(PG8_SA(0, 0), a2, voffA);
            PG8_BAR; PG8_WAIT_L(0); PG8_MMA(1, 0, At, B0); PG8_BAR; PG8_SCHED;
            PG8_STAGE(PG8_SB(0, 1), b2 + hstep, voffB);
            PG8_WAIT_V(6); PG8_BAR; PG8_MMA(1, 1, At, B1); PG8_BAR;
            PG8_LDB(B0, 1, 0); PG8_SCHED; PG8_LDA(At, 1, 0); PG8_STAGE(PG8_SA(0, 1), a2 + hstep, voffA);
            PG8_WAIT_L(8); PG8_BAR; PG8_WAIT_L(0); PG8_MMA(0, 0, At, B0); PG8_BAR; PG8_SCHED;
            PG8_LDB(B1, 1, 1); PG8_STAGE(PG8_SB(1, 0), b3, voffB);
            PG8_BAR; PG8_WAIT_L(0); PG8_MMA(0, 1, At, B1); PG8_BAR;
            PG8_LDA(At, 1, 1); PG8_STAGE(PG8_SA(1, 0), a3, voffA);
            PG8_BAR; PG8_WAIT_L(0); PG8_MMA(1, 0, At, B0); PG8_BAR; PG8_SCHED;
            PG8_STAGE(PG8_SB(1, 1), b3 + hstep, voffB);
            PG8_WAIT_V(6); PG8_BAR; PG8_MMA(1, 1, At, B1); PG8_BAR;
            }
        }
        if constexpr (ALIGN_EPI) { if (wr == 0) PG8_BAR; }
        if constexpr (!Epi::AFTER_DRAIN) { E(acc, cur, wr, wc, fr, fq); S.done(cur); }
        if (!has_next) break;
#pragma unroll
        for (int a = 0; a < 2; ++a)
#pragma unroll
            for (int b = 0; b < 2; ++b)
#pragma unroll
                for (int m = 0; m < 4; ++m)
#pragma unroll
                    for (int n = 0; n < 2; ++n) acc[a][b][m][n] = (f32x4){0.f, 0.f, 0.f, 0.f};
        cur = nxt; cA = nA; cB = nB; ++ui;
        if constexpr (ALIGN_EPI) { if (wr == 1) PG8_BAR; }
    }
    PG8_WAIT_V(0);
    if constexpr (!ALIGN_EPI) { if (wr == 0) PG8_BAR; }
    PG8_BAR;
    if constexpr (Epi::AFTER_DRAIN) { E.fused(acc, cur, wr, wc, fr, fq, lds, wid, lane); S.done(cur); }
#undef PG8_SA
#undef PG8_SB
#undef PG8_STAGE
#undef PG8_LDA
#undef PG8_LDB
#undef PG8_MMA
#undef PG8_WAIT_V
#undef PG8_WAIT_L
#undef PG8_BAR
#undef PG8_SCHED
}
}

using pg8::bf16_t; using pg8::bf16x8; using pg8::f32x4; using pg8::u32x4; using pg8::pk2; using pg8::pk8;
typedef float f32x16 __attribute__((ext_vector_type(16)));
typedef unsigned u32x2 __attribute__((ext_vector_type(2)));
constexpr int NWAVES = 8;
#define GAS __attribute__((address_space(1)))
#define LAS __attribute__((address_space(3)))
typedef GAS unsigned gu32;
#define RLX_AGENT __ATOMIC_RELAXED, __HIP_MEMORY_SCOPE_AGENT
#define LDS_WAIT() asm volatile("s_waitcnt lgkmcnt(0)" ::: "memory")
#define VM_WAIT() asm volatile("s_waitcnt vmcnt(0)" ::: "memory")

constexpr size_t MiB = 1u << 20;
constexpr size_t WS_CTL = 0, CTL_ZERO_BYTES = 1 * MiB;
constexpr size_t WS_TAB = 1 * MiB;
constexpr size_t WS_W1I = 2 * MiB;
constexpr size_t WS_W1O = WS_W1I + (size_t)2 * FF * DM * 2;
constexpr size_t WS_KN  = WS_W1I;
constexpr size_t WS_HB  = WS_W1O + (size_t)DM * FF * 2;
constexpr size_t WS_WIN = WS_HB + (size_t)MTOK * DM * 2;
constexpr size_t WS_WUQ = WS_WIN + (size_t)NIN * DM * 2;
constexpr size_t WS_WKV = WS_WUQ + (size_t)1536 * 512 * 2;
constexpr size_t WS_WBS = WS_WKV + (size_t)2048 * 512 * 2;
constexpr size_t WS_WBM = WS_WBS + (size_t)DM * 1024 * 2;
constexpr size_t WS_WO  = WS_WBM + (size_t)DM * 1024 * 2;
constexpr size_t WS_W2I = WS_WO + (size_t)DM * DM * 2;
constexpr size_t WS_W2O = WS_W2I + (size_t)2 * FF * DM * 2;
constexpr size_t WS_ACT = WS_W2O + (size_t)DM * FF * 2;
constexpr size_t WS_G   = WS_ACT;
constexpr size_t WS_Y   = WS_ACT + (size_t)MTOK * FF * 2;
constexpr size_t WS_VT  = WS_Y;
constexpr size_t WS_T   = WS_Y;
constexpr size_t WS_H   = WS_Y + (size_t)MTOK * DM * 4;
constexpr size_t WS_QM  = WS_H;
constexpr size_t WS_QS  = WS_H + (size_t)MTOK * DM * 4;
constexpr size_t WS_CQ  = WS_QS + (size_t)MTOK * 1024 * 2;
constexpr size_t WS_CKV = WS_CQ + (size_t)MTOK * 512 * 4;
constexpr size_t WS_KR  = WS_CKV + (size_t)MTOK * 512 * 4;
constexpr size_t WS_OSB = WS_CQ;
constexpr size_t WS_OML = WS_OSB + (size_t)MTOK * 1024 * 2;
constexpr size_t WS_CKA = WS_KR + (size_t)MTOK * 64 * 4;
constexpr size_t WS_CQB = WS_CKA + (size_t)KROWS * 512 * 2;
constexpr size_t WS_MG  = WS_CKA;
constexpr size_t WS_KRB = WS_CKA + (size_t)MTOK * DM * 2;
constexpr size_t WS_END = WS_KRB + (size_t)NPROMPT * 64 * 2;
static_assert(WS_OML + (size_t)MTOK * 1024 * 2 <= WS_CKA && WS_CQB + (size_t)MTOK * 512 * 2 <= WS_KRB && WS_KN + (size_t)(KROWS + 32) * 1024 * 2 <= WS_HB && WS_VT + (size_t)1024 * VPITCH * 2 <= WS_H, "d_ws map");
static_assert(WS_KN + (size_t)16 * NSAMPLE * DM * 2 <= WS_HB && WS_CQ + (size_t)16 * NSAMPLE * DM * 2 <= WS_CKA, "split-K slabs");
static_assert(WS_END <= (size_t)600 * MiB && (WS_W1O % 256) == 0 && (WS_CKA % 256) == 0 && (WS_CQB % 256) == 0, "d_ws map");
constexpr size_t O_YP = 0, O_YS = 16777216, O_KP = 17301504, O_VP = 25690112, O_CKVP = 34078720, O_KRP = 38273024, O_KS = 38797312, O_VS = 39059456, O_CKVS = 39321600, O_KRS = 39452672, O_END = 39469056;
constexpr int CW_TMO = 0, CW_BAR = 4096;
constexpr int RING_BYTES = 131072, LDSCTL_OFF = RING_BYTES, MISC_OFF = LDSCTL_OFF + 320, LDS_BYTES = 147456;
#define XB_TMO      128
#define XB_XCNT(j)  (256  + 64 * (j))
#define XB_XSUB(j)  (1280 + 64 * (j))
#define XB_XGEN(j)  (2304 + 64 * (j))
#define XB_TOP      3328
#define XB_TOPGEN   3392
#define XCD_BAR_WORDS 3456
#define XB_SPIN_CAP (1u << 18)

__device__ __forceinline__ unsigned xb_ld(unsigned* p)              { return __hip_atomic_load(p, __ATOMIC_RELAXED, __HIP_MEMORY_SCOPE_AGENT); }
__device__ __forceinline__ unsigned xb_add(unsigned* p, unsigned v) { return __hip_atomic_fetch_add(p, v, __ATOMIC_RELAXED, __HIP_MEMORY_SCOPE_AGENT); }
__device__ __forceinline__ unsigned xb_xcc_id() { return (unsigned)__builtin_amdgcn_s_getreg((3 << 11) | 20) & 0xFu; }
#define XB_SPIN(cond, bar) do { unsigned _sp = 0; while (cond) { __builtin_amdgcn_s_sleep(1); \
    if ((++_sp & 255u) == 0u) { if (xb_ld(&(bar)[XB_TMO])) break; if (_sp > XB_SPIN_CAP) { atomicAdd(&(bar)[XB_TMO], 1u); break; } } } } while (0)

struct XcdBarrier {
    unsigned* bar; unsigned x;
    volatile LAS unsigned* st;
};

__device__ __forceinline__ XcdBarrier xcd_barrier_post(unsigned* bar, volatile LAS unsigned* st) {
    XcdBarrier b; b.bar = bar; b.x = xb_xcc_id(); b.st = st;
    if (threadIdx.x == 0) (void)xb_add(&bar[XB_XCNT(b.x)], 1u);
    return b;
}
__device__ __forceinline__ void xcd_barrier_complete(unsigned* bar, unsigned x, unsigned& nloc, unsigned& nx) {
    const unsigned G = gridDim.x * gridDim.y * gridDim.z;
    unsigned sum, cnt, mine, sp = 0u;
    for (;;) {
        sum = 0u; cnt = 0u; mine = 0u;
#pragma unroll
        for (unsigned j = 0; j < 16; ++j) { const unsigned c = xb_ld(&bar[XB_XCNT(j)]); sum += c; cnt += (c > 0u) ? 1u : 0u; mine = (j == x) ? c : mine; }
        if (sum == G) break;
        __builtin_amdgcn_s_sleep(1);
        if ((++sp & 255u) == 0u) { if (xb_ld(&bar[XB_TMO])) break; if (sp > XB_SPIN_CAP) { atomicAdd(&bar[XB_TMO], 1u); break; } }
    }
    nloc = mine > 0u ? mine : 1u; nx = cnt > 0u ? cnt : 1u;
}

__device__ __forceinline__ void xcd_barrier(const XcdBarrier& b) {
    asm volatile("s_waitcnt vmcnt(0)" ::: "memory");
    __syncthreads();
    if (threadIdx.x == 0) {
        unsigned* bar = b.bar;
        __builtin_amdgcn_s_waitcnt(0);
        unsigned nloc = b.st[0], nx = b.st[1];
        if (nloc == 0u) { xcd_barrier_complete(bar, b.x, nloc, nx); b.st[0] = nloc; b.st[1] = nx; }
        const unsigned old = xb_add(&bar[XB_XSUB(b.x)], 1u);
        const unsigned gen = old / nloc;
        if (old + 1u == (gen + 1u) * nloc) {
            __builtin_amdgcn_fence(__ATOMIC_RELEASE, "agent");
            asm volatile("s_waitcnt vmcnt(0)" ::: "memory");
            const unsigned og = xb_add(&bar[XB_TOP], 1u);
            const unsigned tg = og / nx;
            if (og + 1u == (tg + 1u) * nx) xb_add(&bar[XB_TOPGEN], 1u);
            else XB_SPIN(xb_ld(&bar[XB_TOPGEN]) == tg, bar);
            __builtin_amdgcn_fence(__ATOMIC_ACQUIRE, "agent");
            xb_add(&bar[XB_XGEN(b.x)], 1u);
            asm volatile("s_waitcnt vmcnt(0)" ::: "memory");
        } else {
            XB_SPIN(xb_ld(&bar[XB_XGEN(b.x)]) == gen, bar);
            __builtin_amdgcn_fence(__ATOMIC_ACQUIRE, "agent");
            asm volatile("s_waitcnt vmcnt(0)" ::: "memory");
        }
    }
    __syncthreads();
}

__device__ __forceinline__ float wave_sum(float v) {
#pragma unroll
    for (int o = 1; o < 64; o <<= 1) v += __shfl_xor(v, o);
    return v;
}
__device__ __forceinline__ void transpose_item(const float* W, int ldw, int k0, int n0, bf16_t* WT, int ldt, int drow0, LAS float* scr, int lane) {
#pragma unroll 8
    for (int i = 0; i < 32; ++i) { const int kk = 2 * i + (lane >> 5); scr[kk * 33 + (lane & 31)] = W[(size_t)(k0 + kk) * ldw + n0 + (lane & 31)]; }
    LDS_WAIT(); asm volatile("" ::: "memory");
    const int c = lane & 7;
#pragma unroll
    for (int j = 0; j < 4; ++j) { const int n = (lane >> 3) + 8 * j; const LAS float* s = scr + (8 * c) * 33 + n;
        u32x4 o; o.x = pk2(s[0 * 33], s[1 * 33]); o.y = pk2(s[2 * 33], s[3 * 33]); o.z = pk2(s[4 * 33], s[5 * 33]); o.w = pk2(s[6 * 33], s[7 * 33]);
        *(u32x4*)(WT + (size_t)(drow0 + n) * ldt + k0 + 8 * c) = o; }
    LDS_WAIT(); asm volatile("" ::: "memory");
}
template <int MAP> __device__ __forceinline__ int map_row(int n0) {
    if (MAP == 1) { const int j = n0 < FF ? n0 : n0 - FF; return ((j >> 7) << 8) + (j & 127) + (n0 < FF ? 0 : 128); }
    if (MAP == 2) { return n0 < 4096 ? n0 : (n0 < 4160 ? 8192 + (n0 - 4096) : 4096 + (n0 - 4160)); }
    if (MAP == 3) { const int h = n0 >> 8, r = n0 & 255; return r < 128 ? h * 128 + r : 1024 + h * 128 + (r - 128); }
    return n0;
}
template <int MAP> __device__ __forceinline__ void transpose_matrix(const float* W, int K, int N, bf16_t* WT, LAS float* scr, int gw, int NGW, int lane) {
    const int nnb = N / 32, nit = (K / 64) * nnb;
    for (int it = gw; it < nit; it += NGW) { const int kb = it / nnb, nb = it - kb * nnb; transpose_item(W, N, kb * 64, nb * 32, WT, K, map_row<MAP>(nb * 32), scr, lane); }
}
__device__ __forceinline__ int tok_pos(int m) { return m < NPROMPT ? (m & (SEQ - 1)) : PAST + ((m - NPROMPT) & (DEC_T - 1)); }
__device__ __forceinline__ int tok_krow(int m) { return m < NPROMPT ? m : NPROMPT + ((m - NPROMPT) >> 4) * KEYS_S + PAST + ((m - NPROMPT) & 15); }

__device__ __forceinline__ void ln_row_finish(f32x4 (&v)[8], const float* gam, const float* bet, float* frow, bf16_t* brow, int lane) {
    float s = 0.f;
#pragma unroll
    for (int j = 0; j < 8; ++j) s += (v[j][0] + v[j][1]) + (v[j][2] + v[j][3]);
    const float mean = wave_sum(s) * (1.f / DM); float s2 = 0.f;
#pragma unroll
    for (int j = 0; j < 8; ++j) { v[j] = v[j] - mean; s2 += (v[j][0] * v[j][0] + v[j][1] * v[j][1]) + (v[j][2] * v[j][2] + v[j][3] * v[j][3]); }
    const float rstd = 1.f / sqrtf(wave_sum(s2) * (1.f / DM) + LN_EPS);
    f32x4* fo = (f32x4*)frow + lane; u32x2* bo = (u32x2*)brow + lane;
#pragma unroll
    for (int j = 0; j < 8; ++j) { const f32x4 g = ((const f32x4*)gam)[64 * j + lane], b = ((const f32x4*)bet)[64 * j + lane]; const f32x4 o = v[j] * rstd * g + b;
        if (frow) fo[64 * j] = o; if (brow) { u32x2 w; w.x = pk2(o[0], o[1]); w.y = pk2(o[2], o[3]); bo[64 * j] = w; } }
}
template <int NCH, bool RBF>
__device__ __forceinline__ void ln_phase(LAS unsigned char* lds, const bf16_t* Y, const float* gam, const float* bet, float* F0, float* F1, bf16_t* HBo, const bf16_t* slab, const void* R1, float alpha, float sc, int bx, int G, int tid, int wave, int lane) {
    const int gw = bx * NWAVES + wave, NGW = G * NWAVES;
    for (int sr = bx; sr < NSAMPLE; sr += G) {
        const u32x2* sp = (const u32x2*)(slab + (size_t)sr * DM) + tid;
        f32x4 a = {0.f, 0.f, 0.f, 0.f};
#pragma unroll
        for (int c = 0; c < NCH; ++c) { const u32x2 w = sp[(size_t)c * (NSAMPLE * DM / 4)]; a += (f32x4){pg8::bf_lo(w.x), pg8::bf_hi(w.x), pg8::bf_lo(w.y), pg8::bf_hi(w.y)}; }
        f32x4 rr;
        if (RBF) { const u32x2 w = ((const u32x2*)((const bf16_t*)R1 + (size_t)sr * DM))[tid]; rr = (f32x4){pg8::bf_lo(w.x), pg8::bf_hi(w.x), pg8::bf_lo(w.y), pg8::bf_hi(w.y)}; }
        else rr = ((const f32x4*)((const float*)R1 + (size_t)sr * DM))[tid];
        ((LAS f32x4*)lds)[tid] = rr * alpha + a * sc;
        __syncthreads();
        if (wave == 0) { f32x4 v[8];
#pragma unroll
            for (int j = 0; j < 8; ++j) v[j] = ((const LAS f32x4*)lds)[64 * j + lane];
            ln_row_finish(v, gam, bet, F1 ? F1 + (size_t)sr * DM : nullptr, HBo ? HBo + (size_t)(NPROMPT + sr) * DM : nullptr, lane); }
        __syncthreads();
    }
    for (int m = gw; m < NPROMPT; m += NGW) {
        const u32x2* yr = (const u32x2*)(Y + (size_t)m * DM) + lane; f32x4 v[8];
#pragma unroll
        for (int j = 0; j < 8; ++j) { const u32x2 w = yr[64 * j]; v[j] = (f32x4){pg8::bf_lo(w.x), pg8::bf_hi(w.x), pg8::bf_lo(w.y), pg8::bf_hi(w.y)}; }
        ln_row_finish(v, gam, bet, F0 ? F0 + (size_t)m * DM : nullptr, HBo ? HBo + (size_t)m * DM : nullptr, lane);
    }
}

#define MFMA32(a, b, c) __builtin_amdgcn_mfma_f32_32x32x16_bf16((a), (b), (c), 0, 0, 0)
__device__ __forceinline__ bf16x8 pack8f(const f32x4 a, const f32x4 b) { return __builtin_bit_cast(bf16x8, pk8(a, b)); }
__device__ __forceinline__ int pi32(int r) { return (r & ~12) | ((r & 4) << 1) | ((r & 8) >> 1); }
__device__ __forceinline__ void store_ot(bf16_t* op, const f32x16 (&o)[4], float sc, int hi) {
#pragma unroll
    for (int dt = 0; dt < 4; ++dt)
#pragma unroll
        for (int g = 0; g < 4; ++g) { u32x2 w; w.x = pk2(o[dt][4 * g] * sc, o[dt][4 * g + 1] * sc); w.y = pk2(o[dt][4 * g + 2] * sc, o[dt][4 * g + 3] * sc);
            *(u32x2*)(op + dt * 32 + 8 * g + 4 * hi) = w; }
}

__device__ __forceinline__ void sb_scores(const bf16x8 (&kf)[8], const bf16x8 (&qf)[8], bool diag, int key0, int qpos, int hi, float& R, bf16x8& pf0, bf16x8& pf1) {
    f32x16 st;
#pragma unroll
    for (int i = 0; i < 16; ++i) st[i] = 0.f;
#pragma unroll
    for (int ks = 0; ks < 8; ++ks) st = MFMA32(kf[ks], qf[ks], st);
    float l1[16], lb[16];
#pragma unroll
    for (int i = 0; i < 16; ++i) { const float zz = st[i]; const float e = __builtin_amdgcn_exp2f(-__builtin_fabsf(zz)); const float sp = fmaxf(zz, 0.f) + __builtin_amdgcn_logf(1.f + e);
        l1[i] = -sp; lb[i] = zz - sp;
        if (diag) { const int key = key0 + 16 * (i >> 3) + 8 * hi + (i & 7); const bool vis = key < qpos; l1[i] = vis ? l1[i] : 0.f; lb[i] = vis ? lb[i] : -INFINITY; } }
    float g0 = 0.f, g1 = 0.f;
#pragma unroll
    for (int i = 0; i < 8; ++i) { g0 += l1[i]; g1 += l1[8 + i]; }
    const float pg0 = __shfl_xor(g0, 32), pg1 = __shfl_xor(g1, 32);
    float p[16];
    { float run = R + (hi ? 0.f : pg1);
#pragma unroll
      for (int i = 15; i >= 8; --i) { p[i] = __builtin_amdgcn_exp2f(lb[i] + run); run += l1[i]; }
      run = R + g1 + pg1 + (hi ? 0.f : pg0);
#pragma unroll
      for (int i = 7; i >= 0; --i) { p[i] = __builtin_amdgcn_exp2f(lb[i] + run); run += l1[i]; } }
    R += (g0 + g1) + (pg0 + pg1);
    pf0 = pack8f((f32x4){p[0], p[1], p[2], p[3]}, (f32x4){p[4], p[5], p[6], p[7]}); pf1 = pack8f((f32x4){p[8], p[9], p[10], p[11]}, (f32x4){p[12], p[13], p[14], p[15]});
}
constexpr int SK_PITCH = 272, SV_PITCH = 136, SK_BYTES = 64 * SK_PITCH, SV_BYTES = 128 * SV_PITCH, ST_BYTES = SK_BYTES + SV_BYTES;
static_assert(2 * ST_BYTES + 64 <= RING_BYTES && 8 * 32 * 4 + 9 * 64 * 32 * 4 <= RING_BYTES, "SB LDS");
__device__ __forceinline__ void sb_prompt_unit(LAS unsigned char* lds, int b, int h, int j, const bf16_t* QS, const float* Kp, const float* Vp, bf16_t* OSB, int tid, int lane, int wave) {
    const int r = lane & 31, hi = lane >> 5;
    const int Q0 = j * 256, qpos = Q0 + 32 * wave + r, qrow = b * SEQ + qpos, NT = (Q0 + 256) / 64;
    const bf16_t* qp = QS + (size_t)qrow * 1024 + h * 128 + 8 * hi;
    bf16x8 qf[8];
#pragma unroll
    for (int ks = 0; ks < 8; ++ks) qf[ks] = *(const bf16x8*)(qp + 16 * ks);
    f32x16 o[4];
#pragma unroll
    for (int dt = 0; dt < 4; ++dt)
#pragma unroll
        for (int i = 0; i < 16; ++i) o[dt][i] = 0.f;
    float R = 0.f; int done = 0;
    volatile LAS int* flags = (volatile LAS int*)(lds + 2 * ST_BYTES);
    const float* gK = Kp + (size_t)(b * SEQ) * 1024 + h * 128;
    const float* gV = Vp + (size_t)(b * SEQ) * 1024 + h * 128;
    f32x4 ka[2][2]; float va[8][2];
#define SB_ISSUE(t) do { const int kb_ = Q0 + 256 - 64 * ((t) + 1); \
        _Pragma("unroll") for (int jj = 0; jj < 2; ++jj) { const int idx = tid + 512 * jj; const float* p_ = gK + (size_t)(kb_ + (idx >> 4)) * 1024 + (idx & 15) * 8; ka[jj][0] = *(const f32x4*)p_; ka[jj][1] = *(const f32x4*)(p_ + 4); } \
        _Pragma("unroll") for (int jj = 0; jj < 8; ++jj) { const int idx = tid + 512 * jj; const float* p_ = gV + (size_t)(kb_ + 2 * (idx >> 7)) * 1024 + (idx & 127); va[jj][0] = p_[0]; va[jj][1] = p_[1024]; } } while (0)
#define SB_COMMIT(buf) do { LAS unsigned char* B_ = lds + (buf) * ST_BYTES; \
        _Pragma("unroll") for (int jj = 0; jj < 2; ++jj) { const int idx = tid + 512 * jj; *(LAS u32x4*)(B_ + (idx >> 4) * SK_PITCH + (idx & 15) * 16) = pk8(ka[jj][0], ka[jj][1]); } \
        _Pragma("unroll") for (int jj = 0; jj < 8; ++jj) { const int idx = tid + 512 * jj; *(LAS unsigned*)(B_ + SK_BYTES + (idx & 127) * SV_PITCH + (idx >> 7) * 4) = pk2(va[jj][0], va[jj][1]); } } while (0)
    const int pr = pi32(r);
    SB_ISSUE(0); SB_COMMIT(0); __syncthreads();
    for (int t = 0; t < NT; ++t) {
        if (t + 1 < NT) SB_ISSUE(t + 1);
        const int kbase = Q0 + 256 - 64 * (t + 1);
        const LAS unsigned char* Bt = lds + (t & 1) * ST_BYTES;
#pragma unroll
        for (int sub = 1; sub >= 0; --sub) {
            const int key0 = kbase + 32 * sub;
            if (!done && key0 <= Q0 + 32 * wave) {
                bf16x8 kf[8];
                { const LAS unsigned char* kp = Bt + (32 * sub + pr) * SK_PITCH + hi * 16;
#pragma unroll
                  for (int ks = 0; ks < 8; ++ks) kf[ks] = *(const LAS bf16x8*)(kp + ks * 32); }
                bf16x8 pf0, pf1; sb_scores(kf, qf, key0 == Q0 + 32 * wave, key0, qpos, hi, R, pf0, pf1);
                const LAS unsigned char* vp = Bt + SK_BYTES + r * SV_PITCH + (32 * sub + 8 * hi) * 2;
#pragma unroll
                for (int dt = 0; dt < 4; ++dt) {
                    const u32x2 a0 = *(const LAS u32x2*)(vp + dt * 32 * SV_PITCH), a1 = *(const LAS u32x2*)(vp + dt * 32 * SV_PITCH + 8), c0 = *(const LAS u32x2*)(vp + dt * 32 * SV_PITCH + 32), c1 = *(const LAS u32x2*)(vp + dt * 32 * SV_PITCH + 40);
                    o[dt] = MFMA32(__builtin_bit_cast(bf16x8, (u32x4){a0.x, a0.y, a1.x, a1.y}), pf0, o[dt]); o[dt] = MFMA32(__builtin_bit_cast(bf16x8, (u32x4){c0.x, c0.y, c1.x, c1.y}), pf1, o[dt]); }
                if (__all(R < -160.f)) done = 1;
            }
        }
        if (lane == 0) flags[(t & 1) * 8 + wave] = done;
        if (t + 1 < NT) SB_COMMIT((t + 1) & 1);
        __syncthreads();
        int alld = 1;
#pragma unroll
        for (int w = 0; w < 8; ++w) alld &= flags[(t & 1) * 8 + w];
        if (alld) break;
    }
#undef SB_ISSUE
#undef SB_COMMIT
    store_ot(OSB + (size_t)qrow * 1024 + h * 128, o, 1.f, hi);
    __syncthreads();
}
__device__ __forceinline__ void sb_sample_unit(LAS unsigned char* lds, int b, int h, const bf16_t* QS, const float* cK, const float* cV, const float* nK, const float* nV, bf16_t* OSB, int lane, int wave) {
    const int r = lane & 31, hi = lane >> 5;
    const int qi = r < DEC_T ? r : DEC_T - 1, qpos = PAST + qi, qrow = NPROMPT + b * DEC_T + qi, cl = hi * 16 + (r & 15);
    const bool valid = r < DEC_T;
    const bf16_t* qp = QS + (size_t)qrow * 1024 + h * 128 + 8 * hi;
    bf16x8 qf[8];
#pragma unroll
    for (int ks = 0; ks < 8; ++ks) qf[ks] = *(const bf16x8*)(qp + 16 * ks);
    float Rcarry = 0.f;
    LAS float* RT = (LAS float*)lds;
    LAS float* OP = (LAS float*)(lds + 8 * 32 * 4);
    LAS float* OA = OP + 8 * 64 * 32;
    if (wave == 0 && valid) {
#pragma unroll
        for (int i = 0; i < 64; ++i) OA[i * 32 + cl] = 0.f; }
    const int pr = pi32(r);
    for (int base = PAST / 32; base >= 0; base -= NWAVES) {
        const int kt = base - wave;
        f32x16 o[4];
#pragma unroll
        for (int dt = 0; dt < 4; ++dt)
#pragma unroll
            for (int i = 0; i < 16; ++i) o[dt][i] = 0.f;
        float Rl = 0.f;
        if (kt >= 0) {
            const float* Kb; const float* Vb; int nvalid = 32;
            if (kt < PAST / 32) { const size_t off = ((size_t)b * PAST + kt * 32) * 1024 + h * 128; Kb = cK + off; Vb = cV + off; }
            else { const size_t off = (size_t)(b * DEC_T) * 1024 + h * 128; Kb = nK + off; Vb = nV + off; nvalid = DEC_T; }
            bf16x8 kf[8];
            { const float* kr = Kb + (size_t)(pr < nvalid ? pr : nvalid - 1) * 1024 + 8 * hi;
#pragma unroll
              for (int ks = 0; ks < 8; ++ks) kf[ks] = pack8f(*(const f32x4*)(kr + 16 * ks), *(const f32x4*)(kr + 16 * ks + 4)); }
            bf16x8 pf0, pf1; sb_scores(kf, qf, kt == PAST / 32, kt * 32, qpos, hi, Rl, pf0, pf1);
#pragma unroll
            for (int s2 = 0; s2 < 2; ++s2) { float vv[4][8];
#pragma unroll
                for (int jj = 0; jj < 8; ++jj) { const int kl = 16 * s2 + 8 * hi + jj; const float* vp = Vb + (size_t)(kl < nvalid ? kl : nvalid - 1) * 1024 + r;
#pragma unroll
                    for (int dt = 0; dt < 4; ++dt) vv[dt][jj] = vp[32 * dt]; }
#pragma unroll
                for (int dt = 0; dt < 4; ++dt) o[dt] = MFMA32(pack8f((f32x4){vv[dt][0], vv[dt][1], vv[dt][2], vv[dt][3]}, (f32x4){vv[dt][4], vv[dt][5], vv[dt][6], vv[dt][7]}), s2 ? pf1 : pf0, o[dt]); }
        }
        if (valid) RT[wave * 32 + cl] = Rl;
        __syncthreads();
        float Rpre = Rcarry, Rall = Rcarry;
#pragma unroll
        for (int w = 0; w < NWAVES; ++w) { const float x = RT[w * 32 + cl]; Rall += x; Rpre += (w < wave) ? x : 0.f; }
        const float sc = __builtin_amdgcn_exp2f(Rpre);
        if (valid) {
#pragma unroll
            for (int dt = 0; dt < 4; ++dt)
#pragma unroll
                for (int i = 0; i < 16; ++i) OP[(wave * 64 + dt * 16 + i) * 32 + cl] = o[dt][i] * sc; }
        __syncthreads();
        if (wave == 0 && valid) {
#pragma unroll 4
            for (int i = 0; i < 64; ++i) { float a = OA[i * 32 + cl];
#pragma unroll
                for (int w = 0; w < NWAVES; ++w) a += OP[(w * 64 + i) * 32 + cl];
                OA[i * 32 + cl] = a; } }
        Rcarry = Rall;
        __syncthreads();
        if (__all(Rcarry < -160.f)) break;
    }
    if (wave == 0 && valid) { f32x16 oacc[4];
#pragma unroll
        for (int dt = 0; dt < 4; ++dt)
#pragma unroll
            for (int i = 0; i < 16; ++i) oacc[dt][i] = OA[(dt * 16 + i) * 32 + cl];
        store_ot(OSB + (size_t)qrow * 1024 + h * 128, oacc, 1.f, hi); }
    __syncthreads();
}

__device__ __forceinline__ void mla_softmax_pv_prep(const f32x16& st, f32x16 (&o)[4], float& mrun, float& lsum, bf16x8& pf0, bf16x8& pf1) {
    float mx = st[0];
#pragma unroll
    for (int i = 1; i < 16; ++i) mx = fmaxf(mx, st[i]);
    mx = fmaxf(mx, __shfl_xor(mx, 32));
    if (!__all(mx - mrun <= 6.f)) { const float mnew = fmaxf(mrun, mx), alpha = __builtin_amdgcn_exp2f(mrun - mnew); lsum *= alpha; mrun = mnew;
#pragma unroll
        for (int dt = 0; dt < 4; ++dt)
#pragma unroll
            for (int i = 0; i < 16; ++i) o[dt][i] *= alpha; }
    float p[16], ps = 0.f;
#pragma unroll
    for (int i = 0; i < 16; ++i) { p[i] = __builtin_amdgcn_exp2f(st[i] - mrun); ps += p[i]; }
    lsum += ps;
    pf0 = pack8f((f32x4){p[0], p[1], p[2], p[3]}, (f32x4){p[4], p[5], p[6], p[7]}); pf1 = pack8f((f32x4){p[8], p[9], p[10], p[11]}, (f32x4){p[12], p[13], p[14], p[15]});
}
constexpr int MK_PITCH = 400, MV_PITCH = 144, MK_BYTES = 64 * MK_PITCH, MV_BYTES = 128 * MV_PITCH, MT_BYTES = MK_BYTES + MV_BYTES;
static_assert(2 * MT_BYTES <= RING_BYTES && 4 * 64 * 66 * 4 <= RING_BYTES, "MLA LDS");
__device__ __forceinline__ void mla_prompt_unit(LAS unsigned char* lds, int b, int h, int qi, const bf16_t* QM, const bf16_t* KN, const bf16_t* VT, const bf16_t* krP, bf16_t* OML, int tid, int lane, int wave) {
    const int r = lane & 31, hi = lane >> 5, qsub = wave & 3, kgrp = wave >> 2;
    const int qrow = b * SEQ + qi * 128 + qsub * 32 + r, NT = 2 * qi + 2, ntw = (qsub < 2) ? NT - 1 : NT, krow0 = b * SEQ;
    const bf16_t* qp = QM + (size_t)qrow * 1536 + h * 192 + 8 * hi;
    bf16x8 qf[12];
#pragma unroll
    for (int ks = 0; ks < 12; ++ks) qf[ks] = *(const bf16x8*)(qp + 16 * ks);
    f32x16 o[4];
#pragma unroll
    for (int dt = 0; dt < 4; ++dt)
#pragma unroll
        for (int i = 0; i < 16; ++i) o[dt][i] = 0.f;
    float mrun = -1e30f, lsum = 0.f;
    const int kr0 = tid >> 4, kc0 = tid & 15, rr = tid >> 3, rc = tid & 7;
    const bf16_t* gk = KN + (size_t)(krow0 + kr0) * 1024 + h * 128 + kc0 * 8;
    const bf16_t* gr = krP + (size_t)(krow0 + rr) * 64 + 8 * rc;
    const bf16_t* gv = VT + (size_t)(h * 128 + rr) * VPITCH + krow0 + rc * 8;
    const int lk = kr0 * MK_PITCH + kc0 * 16, lr = rr * MK_PITCH + 256 + rc * 16, lv = MK_BYTES + rr * MV_PITCH + rc * 16;
    u32x4 ak0, ak1, av0, av1, bk0, bk1, bv0, bv1, ar1, br1;
#define MLA_ISSUE(P, t) do { P##k0 = *(const u32x4*)(gk + (size_t)(t) * 65536); P##k1 = *(const u32x4*)(gk + (size_t)(t) * 65536 + 32768); P##r1 = *(const u32x4*)(gr + (size_t)(t) * 4096); \
        P##v0 = *(const u32x4*)(gv + (t) * 64); P##v1 = *(const u32x4*)(gv + (t) * 64 + (size_t)64 * VPITCH); } while (0)
#define MLA_COMMIT(P, buf) do { LAS unsigned char* B_ = lds + (buf) * MT_BYTES; *(LAS u32x4*)(B_ + lk) = P##k0; *(LAS u32x4*)(B_ + lk + 32 * MK_PITCH) = P##k1; \
        *(LAS u32x4*)(B_ + lr) = P##r1; *(LAS u32x4*)(B_ + lv) = P##v0; *(LAS u32x4*)(B_ + lv + 64 * MV_PITCH) = P##v1; } while (0)
#define MLA_COMPUTE(t, buf) do { if ((t) < ntw) { const LAS unsigned char* Bt = lds + (buf) * MT_BYTES; f32x16 st; \
            _Pragma("unroll") for (int i = 0; i < 16; ++i) st[i] = 0.f; \
            _Pragma("unroll") for (int ks = 0; ks < 12; ++ks) st = MFMA32(*(const LAS bf16x8*)(Bt + ko + ks * 32), qf[ks], st); \
            bf16x8 pf0, pf1; mla_softmax_pv_prep(st, o, mrun, lsum, pf0, pf1); \
            _Pragma("unroll") for (int dt = 0; dt < 4; ++dt) { o[dt] = MFMA32(*(const LAS bf16x8*)(Bt + vo + dt * 32 * MV_PITCH), pf0, o[dt]); o[dt] = MFMA32(*(const LAS bf16x8*)(Bt + vo + dt * 32 * MV_PITCH + 32), pf1, o[dt]); } } } while (0)
    const int pr = pi32(r);
    const int ko = (32 * kgrp + pr) * MK_PITCH + hi * 16, vo = MK_BYTES + r * MV_PITCH + (32 * kgrp + 8 * hi) * 2;
    MLA_ISSUE(a, 0); MLA_ISSUE(b, 1); MLA_COMMIT(a, 0); __syncthreads();
    for (int t = 0; t < NT; t += 2) {
        if (t + 2 < NT) MLA_ISSUE(a, t + 2);
        MLA_COMPUTE(t, 0);
        MLA_COMMIT(b, 1);
        __syncthreads();
        if (t + 3 < NT) MLA_ISSUE(b, t + 3);
        MLA_COMPUTE(t + 1, 1);
        if (t + 2 < NT) MLA_COMMIT(a, 0);
        __syncthreads();
    }
#undef MLA_ISSUE
#undef MLA_COMMIT
#undef MLA_COMPUTE
    LAS float* X = (LAS float*)lds;
    if (kgrp == 1) { X[(0 * 4 + qsub) * 64 + lane] = mrun; X[(1 * 4 + qsub) * 64 + lane] = lsum;
#pragma unroll
        for (int dt = 0; dt < 4; ++dt)
#pragma unroll
            for (int i = 0; i < 16; ++i) X[((2 + dt * 16 + i) * 4 + qsub) * 64 + lane] = o[dt][i]; }
    __syncthreads();
    if (kgrp == 0) { const float m2 = X[(0 * 4 + qsub) * 64 + lane], l2 = X[(1 * 4 + qsub) * 64 + lane]; const float mnew = fmaxf(mrun, m2), a1 = __builtin_amdgcn_exp2f(mrun - mnew), a2 = __builtin_amdgcn_exp2f(m2 - mnew);
        lsum = lsum * a1 + l2 * a2;
#pragma unroll
        for (int dt = 0; dt < 4; ++dt)
#pragma unroll
            for (int i = 0; i < 16; ++i) o[dt][i] = o[dt][i] * a1 + X[((2 + dt * 16 + i) * 4 + qsub) * 64 + lane] * a2;
        lsum += __shfl_xor(lsum, 32);
        store_ot(OML + (size_t)qrow * 1024 + h * 128, o, 1.f / lsum, hi); }
    __syncthreads();
}
__device__ __forceinline__ void mla_sample_unit(LAS unsigned char* lds, int b, int h, const bf16_t* QM, const bf16_t* KN, const bf16_t* VT, const float* krC, const float* krN, bf16_t* OML, int lane, int wave) {
    const int r = lane & 31, hi = lane >> 5;
    const int qi = r < DEC_T ? r : DEC_T - 1, qrow = NPROMPT + b * DEC_T + qi, krow0 = NPROMPT + b * KEYS_S;
    const bf16_t* qp = QM + (size_t)qrow * 1536 + h * 192 + 8 * hi;
    bf16x8 qf[12];
#pragma unroll
    for (int ks = 0; ks < 12; ++ks) qf[ks] = *(const bf16x8*)(qp + 16 * ks);
    f32x16 o[4];
#pragma unroll
    for (int dt = 0; dt < 4; ++dt)
#pragma unroll
        for (int i = 0; i < 16; ++i) o[dt][i] = 0.f;
    float mrun = -1e30f, lsum = 0.f;
    const int pr = pi32(r);
    const bf16_t* vbase = VT + (size_t)(h * 128 + r) * VPITCH + krow0 + 8 * hi;
    for (int kt = wave; kt < PAST / 32 + 1; kt += NWAVES) {
        f32x16 st;
#pragma unroll
        for (int i = 0; i < 16; ++i) st[i] = 0.f;
        { const bf16_t* kp = KN + (size_t)(krow0 + kt * 32 + pr) * 1024 + h * 128 + 8 * hi;
#pragma unroll
          for (int ks = 0; ks < 8; ++ks) st = MFMA32(*(const bf16x8*)(kp + 16 * ks), qf[ks], st);
          const float* rp = (kt < PAST / 32) ? krC + ((size_t)b * PAST + kt * 32 + pr) * 64 : krN + (size_t)(b * DEC_T + (pr < DEC_T ? pr : DEC_T - 1)) * 64;
#pragma unroll
          for (int ks = 0; ks < 4; ++ks) { const f32x4 x1 = *(const f32x4*)(rp + 8 * ks + 4 * hi), x2 = *(const f32x4*)(rp + 32 + 8 * ks + 4 * hi);
              st = MFMA32(pack8f((f32x4){x1[0], x2[0], x1[1], x2[1]}, (f32x4){x1[2], x2[2], x1[3], x2[3]}), qf[8 + ks], st); } }
        if (kt == PAST / 32) {
#pragma unroll
            for (int i = 8; i < 16; ++i) st[i] = -INFINITY;
        }
        __builtin_amdgcn_sched_barrier(0);
        bf16x8 pf0, pf1; mla_softmax_pv_prep(st, o, mrun, lsum, pf0, pf1);
        __builtin_amdgcn_sched_barrier(0);
        const bf16_t* vp = vbase + kt * 32;
#pragma unroll
        for (int dt = 0; dt < 4; ++dt) { o[dt] = MFMA32(*(const bf16x8*)(vp + (size_t)dt * 32 * VPITCH), pf0, o[dt]); o[dt] = MFMA32(*(const bf16x8*)(vp + (size_t)dt * 32 * VPITCH + 16), pf1, o[dt]); }
    }
    LAS float* X = (LAS float*)lds;
    const int cl = hi * 16 + r;
    if (wave > 0 && r < DEC_T) { X[(0 * 7 + wave - 1) * 32 + cl] = mrun; X[(1 * 7 + wave - 1) * 32 + cl] = lsum;
#pragma unroll
        for (int dt = 0; dt < 4; ++dt)
#pragma unroll
            for (int i = 0; i < 16; ++i) X[((2 + dt * 16 + i) * 7 + wave - 1) * 32 + cl] = o[dt][i]; }
    __syncthreads();
    if (wave == 0) {
        if (r < DEC_T) {
#pragma unroll 1
            for (int w = 0; w < 7; ++w) { const float m2 = X[(0 * 7 + w) * 32 + cl], l2 = X[(1 * 7 + w) * 32 + cl]; const float mnew = fmaxf(mrun, m2), a1 = __builtin_amdgcn_exp2f(mrun - mnew), a2 = __builtin_amdgcn_exp2f(m2 - mnew);
                lsum = lsum * a1 + l2 * a2; mrun = mnew;
#pragma unroll
                for (int dt = 0; dt < 4; ++dt)
#pragma unroll
                    for (int i = 0; i < 16; ++i) o[dt][i] = o[dt][i] * a1 + X[((2 + dt * 16 + i) * 7 + w) * 32 + cl] * a2; }
        }
        lsum += __shfl_xor(lsum, 32);
        if (r < DEC_T) store_ot(OML + (size_t)qrow * 1024 + h * 128, o, 1.f / lsum, hi);
    }
    __syncthreads();
}

#ifndef MK_N_LAUNCHES
#define MK_N_LAUNCHES 1
#endif
constexpr int NPHASE = 15;
constexpr int N_LAUNCHES = MK_N_LAUNCHES;
static_assert(N_LAUNCHES == 1 || N_LAUNCHES == NPHASE, "MK_N_LAUNCHES is 1 or 15");
__device__ unsigned g_bar[XCD_BAR_WORDS + 64];
constexpr int GB_DONE = XCD_BAR_WORDS;
struct Args { const float* in[25]; float* out; unsigned char* ws; int ph_lo, ph_hi; };
static_assert(sizeof(Args) == 27 * 8 + 8, "Args has no padding");

__global__ void __launch_bounds__(NWAVES * 64, 2) fwd_kernel(Args args) {
    extern __shared__ __attribute__((aligned(16))) unsigned char lds_raw[];
    LAS unsigned char* lds = (LAS unsigned char*)lds_raw;
    volatile LAS unsigned* MISC = (volatile LAS unsigned*)(lds + MISC_OFF);
    const int tid = threadIdx.x, lane = tid & 63, wave = __builtin_amdgcn_readfirstlane(tid >> 6);
    const int G = gridDim.x, bx = blockIdx.x;
    const int gw = bx * NWAVES + wave, NGW = G * NWAVES;
    unsigned char* ws = args.ws; float* out = args.out;
    for (int u = tid; u < (LDS_BYTES - LDSCTL_OFF) / 4; u += NWAVES * 64) ((LAS unsigned*)(lds + LDSCTL_OFF))[u] = 0u;
    __syncthreads();
    XcdBarrier bar; bar.bar = g_bar; bar.x = 0; bar.st = nullptr;
    if (N_LAUNCHES == 1) bar = xcd_barrier_post(g_bar, MISC + 8);
    const int lo = args.ph_lo, hi = args.ph_hi;
#define IN(k) (lo <= (k) && (k) < hi)
#define SEAM(k) do { if (N_LAUNCHES == 1 && IN(k) && IN((k) + 1)) xcd_barrier(bar); } while (0)

    const float* x_p = args.in[0]; const float* x_s = args.in[1]; const float* cache_k = args.in[2]; const float* cache_v = args.in[3]; const float* cache_ckv = args.in[4]; const float* cache_kr = args.in[5];
    float* TAB = (float*)(ws + WS_TAB);
    bf16_t* W1I = (bf16_t*)(ws + WS_W1I); bf16_t* W1O = (bf16_t*)(ws + WS_W1O); bf16_t* WIN = (bf16_t*)(ws + WS_WIN); bf16_t* WUQ = (bf16_t*)(ws + WS_WUQ); bf16_t* WKV = (bf16_t*)(ws + WS_WKV);
    bf16_t* WBS = (bf16_t*)(ws + WS_WBS); bf16_t* WBM = (bf16_t*)(ws + WS_WBM); bf16_t* WO = (bf16_t*)(ws + WS_WO); bf16_t* W2I = (bf16_t*)(ws + WS_W2I); bf16_t* W2O = (bf16_t*)(ws + WS_W2O);
    bf16_t* HB = (bf16_t*)(ws + WS_HB); bf16_t* ACT = (bf16_t*)(ws + WS_ACT); bf16_t* Y = (bf16_t*)(ws + WS_Y); float* H = (float*)(ws + WS_H);
    bf16_t* QS = (bf16_t*)(ws + WS_QS); float* CQ = (float*)(ws + WS_CQ); float* CKV = (float*)(ws + WS_CKV); float* KR = (float*)(ws + WS_KR); bf16_t* Gt = (bf16_t*)(ws + WS_G);
    bf16_t* CKA = (bf16_t*)(ws + WS_CKA); bf16_t* CQB = (bf16_t*)(ws + WS_CQB); bf16_t* QM = (bf16_t*)(ws + WS_QM); bf16_t* KN = (bf16_t*)(ws + WS_KN); bf16_t* VT = (bf16_t*)(ws + WS_VT);
    bf16_t* SLAB = (bf16_t*)(ws + WS_CQ);
    bf16_t* KRB = (bf16_t*)(ws + WS_KRB);
    bf16_t* OSB = (bf16_t*)(ws + WS_OSB); bf16_t* OML = (bf16_t*)(ws + WS_OML); float* T = (float*)(ws + WS_T); bf16_t* MG = (bf16_t*)(ws + WS_MG);

    if (IN(0)) {
        LAS float* scr = (LAS float*)(lds + wave * 16384);
        transpose_matrix<1>(args.in[6], DM, 2 * FF, W1I, scr, gw, NGW, lane);
        { u32x4* z = (u32x4*)(WIN + (size_t)8256 * DM); const u32x4 zero = {0u, 0u, 0u, 0u};
          for (int i = bx * (NWAVES * 64) + tid; i < (NIN - 8256) * DM / 8; i += G * NWAVES * 64) z[i] = zero; }
        for (int m = gw; m < MTOK; m += NGW) { const float* xr = (m < NPROMPT ? x_p + (size_t)m * DM : x_s + (size_t)(m - NPROMPT) * DM) + lane * 8; bf16_t* xo = HB + (size_t)m * DM + lane * 8;
#pragma unroll
            for (int j = 0; j < 4; ++j) *(u32x4*)(xo + j * 512) = pk8(*(const f32x4*)(xr + j * 512), *(const f32x4*)(xr + j * 512 + 4)); }
        for (int i = bx * (NWAVES * 64) + tid; i < SEQ * 32; i += G * NWAVES * 64) { const int pos = i >> 5, fi = i & 31; const float inv = powf(10000.f, -(float)(2 * fi) / 64.f); const float ang = (float)pos * inv;
            TAB[2 * i] = cosf(ang); TAB[2 * i + 1] = sinf(ang); }
    }
    SEAM(0);
    if (IN(1)) { pg8::Gemm g{HB, W1I, MTOK, 2 * FF, DM}; pg8::StaticOrder S; S.init(MTOK, 2 * FF, G, bx, g.K); pg8::EpiSwiGLU E{ACT, FF};
        pg8::gemm_phase<pg8::EpiSwiGLU, pg8::StaticOrder, true, true>(lds, g, S, E);
        constexpr int R1 = (MTOK / 256) * (2 * FF / 256) % 256;
        if (G == 256 ? bx >= R1 : true) { const int fw = (G == 256 ? (bx - R1) : bx) * NWAVES + wave, FNW = (G == 256 ? (256 - R1) : G) * NWAVES; LAS float* scr = (LAS float*)(lds + wave * 16384);
            transpose_matrix<0>(args.in[7], FF, DM, W1O, scr, fw, FNW, lane);
            transpose_matrix<2>(args.in[10], DM, 8256, WIN, scr, fw, FNW, lane);
            transpose_matrix<3>(args.in[15], 512, 2048, WKV, scr, fw, FNW, lane);
        { const float* Wuq = args.in[13];
          for (int rho = fw; rho < 1536; rho += FNW) { const int hh = rho / 192, j = rho - hh * 192; const int src = j < 128 ? rho : hh * 192 + 128 + (((j - 128) & 1) ? 32 + ((j - 128) >> 1) : ((j - 128) >> 1));
              const float* wp = Wuq + src + (size_t)(lane * 8) * 1536; f32x4 a, c;
#pragma unroll
              for (int e = 0; e < 4; ++e) { a[e] = wp[(size_t)e * 1536]; c[e] = wp[(size_t)(4 + e) * 1536]; }
              *(u32x4*)(WUQ + (size_t)rho * 512 + lane * 8) = pk8(a, c); } }
        } }
    SEAM(1);
    if (IN(2)) { pg8::Gemm g{ACT, W1O, MTOK, DM, FF}; pg8::SplitOrder S; S.init(DM, G, bx, g.K); pg8::EpiResid E{x_p, x_s, Y, ALPHA, 0.5f, SLAB};
        pg8::gemm_phase<pg8::EpiResid, pg8::SplitOrder, true, true>(lds, g, S, E); }
    SEAM(2);
    if (IN(3)) ln_phase<pg8::split_nch(FF), false>(lds, Y, args.in[8], args.in[9], nullptr, nullptr, HB, SLAB, x_s, ALPHA, 0.5f, bx, G, tid, wave, lane);
    SEAM(3);
    if (IN(4)) { pg8::Gemm g{HB, WIN, MTOK, NIN, DM}; pg8::StaticOrder S; S.init(MTOK, NIN, G, bx, g.K);
        pg8::EpiWin E{QS, out, CQ, KR, Gt, args.in[11], SBQ_SCALE};
        pg8::gemm_phase<pg8::EpiWin, pg8::StaticOrder, true, true>(lds, g, S, E);
        constexpr int R4 = (MTOK / 256) * (NIN / 256) % 256;
        if (G == 256 ? bx >= R4 : true) { const int fw = (G == 256 ? (bx - R4) : bx) * NWAVES + wave, FNW = (G == 256 ? (256 - R4) : G) * NWAVES; LAS float* scr = (LAS float*)(lds + wave * 16384);
            transpose_matrix<0>(args.in[16], 1024, DM, WBS, scr, fw, FNW, lane);
            transpose_matrix<0>(args.in[17], 1024, DM, WBM, scr, fw, FNW, lane);
            transpose_matrix<0>(args.in[18], DM, DM, WO, scr, fw, FNW, lane);
            transpose_matrix<1>(args.in[21], DM, 2 * FF, W2I, scr, fw, FNW, lane);
            for (int rr = fw; rr < DEC_B * PAST; rr += FNW) { const int b = rr >> 10, key = rr & (PAST - 1); const float* p = cache_ckv + (size_t)rr * 512 + lane * 8;
                *(u32x4*)(CKA + (size_t)(NPROMPT + b * KEYS_S + key) * 512 + lane * 8) = pk8(*(const f32x4*)p, *(const f32x4*)(p + 4)); }
        } }
    SEAM(4);
    if (IN(5)) {
        const float* gcq = args.in[12]; const float* gckv = args.in[14];
        for (int m = gw; m < MTOK; m += NGW) {
            { const float* p = CQ + (size_t)m * 512 + lane * 8; const f32x4 a = *(const f32x4*)p, c = *(const f32x4*)(p + 4);
              const float ss = wave_sum((a[0] * a[0] + a[1] * a[1]) + (a[2] * a[2] + a[3] * a[3]) + (c[0] * c[0] + c[1] * c[1]) + (c[2] * c[2] + c[3] * c[3]));
              const float rs = 1.f / sqrtf(ss * (1.f / 512.f) + RMS_EPS); const f32x4 g0 = *(const f32x4*)(gcq + lane * 8), g1 = *(const f32x4*)(gcq + lane * 8 + 4);
              *(u32x4*)(CQB + (size_t)m * 512 + lane * 8) = pk8(a * rs * g0, c * rs * g1); }
            { const float* p = CKV + (size_t)m * 512 + lane * 8; const f32x4 a = *(const f32x4*)p, c = *(const f32x4*)(p + 4);
              const float ss = wave_sum((a[0] * a[0] + a[1] * a[1]) + (a[2] * a[2] + a[3] * a[3]) + (c[0] * c[0] + c[1] * c[1]) + (c[2] * c[2] + c[3] * c[3]));
              const float rs = 1.f / sqrtf(ss * (1.f / 512.f) + RMS_EPS); const f32x4 g0 = *(const f32x4*)(gckv + lane * 8), g1 = *(const f32x4*)(gckv + lane * 8 + 4);
              const f32x4 y0 = a * rs * g0, y1 = c * rs * g1;
              float* po = (m < NPROMPT ? out + O_CKVP + (size_t)m * 512 : out + O_CKVS + (size_t)(m - NPROMPT) * 512) + lane * 8; *(f32x4*)po = y0; *(f32x4*)(po + 4) = y1;
              *(u32x4*)(CKA + (size_t)tok_krow(m) * 512 + lane * 8) = pk8(y0, y1); }
            if (lane < 32) { const float x1 = KR[(size_t)m * 64 + lane], x2 = KR[(size_t)m * 64 + 32 + lane]; const int pos = tok_pos(m); const float cs = TAB[(size_t)pos * 64 + 2 * lane], sn = TAB[(size_t)pos * 64 + 2 * lane + 1];
              float* po = (m < NPROMPT ? out + O_KRP + (size_t)m * 64 : out + O_KRS + (size_t)(m - NPROMPT) * 64); const float o1 = x1 * cs - x2 * sn, o2 = x2 * cs + x1 * sn; po[lane] = o1; po[32 + lane] = o2; if (m < NPROMPT) ((unsigned*)KRB)[(size_t)m * 32 + lane] = pk2(o1, o2); }
        }
        for (int i = bx * (NWAVES * 64) + tid; i < 1024 * 8; i += G * NWAVES * 64) { const u32x4 zero = {0u, 0u, 0u, 0u}; *(u32x4*)(VT + (size_t)(i >> 3) * VPITCH + KROWS + (i & 7) * 8) = zero; }
    }
    SEAM(5);
    if (IN(6)) {
        { pg8::Gemm g{CQB, WUQ, MTOK, 1536, 512}; pg8::StaticOrder S; S.init(MTOK, 1536, G, bx, g.K); pg8::EpiUq E{QM, TAB, MLAQ_SCALE};
          pg8::gemm_phase<pg8::EpiUq, pg8::StaticOrder, true, true>(lds, g, S, E); }
        { pg8::Gemm g{CKA, WKV, KROWS, 1024, 512}; pg8::StaticOrder S; S.init(KROWS, 1024, G, bx, g.K); pg8::EpiPlain E{KN, 1024};
          pg8::gemm_phase<pg8::EpiPlain, pg8::StaticOrder, true, true>(lds, g, S, E); }
        { pg8::Gemm g{WKV + (size_t)1024 * 512, CKA, 1024, KROWS, 512}; pg8::StaticOrder S; S.init(1024, KROWS, G, bx, g.K); pg8::EpiPlain E{VT, VPITCH};
          pg8::gemm_phase<pg8::EpiPlain, pg8::StaticOrder, true, true>(lds, g, S, E); }
        for (int u = bx; u < 2 * 8 * (SEQ / 256); u += G) sb_prompt_unit(lds, u >> 7, (u >> 4) & 7, u & 15, QS, out + O_KP, out + O_VP, OSB, tid, lane, wave);
        for (int u = (G == 256 ? bx - 128 : bx); u >= 0 && u < DEC_B * 8; u += G) sb_sample_unit(lds, u >> 3, u & 7, QS, cache_k, cache_v, out + O_KS, out + O_VS, OSB, lane, wave);
    }
    SEAM(6);
    if (IN(7)) {
        { const int bh = (bx >> 4) & 15, j = bx & 15;
          for (int c0 = bx; c0 < 256; c0 += G) { const int c = (G == 256) ? ((c0 & 7) * 32 + (c0 >> 3)) : c0;
              const int bh2 = c >> 4, j2 = c & 15;
              mla_prompt_unit(lds, bh2 >> 3, bh2 & 7, 31 - j2, QM, KN, VT, KRB, OML, tid, lane, wave);
              mla_prompt_unit(lds, bh2 >> 3, bh2 & 7, j2, QM, KN, VT, KRB, OML, tid, lane, wave); }
          (void)bh; (void)j; }
        for (int u = bx; u < DEC_B * 8; u += G) mla_sample_unit(lds, u >> 3, u & 7, QM, KN, VT, cache_kr, out + O_KRS, OML, lane, wave);
    }
    SEAM(7);
    if (IN(8)) {
        bf16_t* SL8 = (bf16_t*)(ws + WS_KN);
        { pg8::Gemm g{OSB, WBS, MTOK, DM, 1024}; pg8::SplitOrder S; S.init(DM, G, bx, g.K, 0); pg8::EpiBrSb E{T, Gt, SL8};
          pg8::gemm_phase<pg8::EpiBrSb, pg8::SplitOrder, true, true>(lds, g, S, E); }
        { pg8::Gemm g{OML, WBM, MTOK, DM, 1024}; pg8::SplitOrder S; S.init(DM, G, bx, g.K, 64); pg8::EpiBrMla E{T, Gt, MG, SL8 + (size_t)8 * NSAMPLE * DM};
          pg8::gemm_phase<pg8::EpiBrMla, pg8::SplitOrder, true, true>(lds, g, S, E); }
    }
    SEAM(8);
    if (IN(9)) {
        const u32x2* SL8 = (const u32x2*)(ws + WS_KN);
        for (int sr = bx; sr < NSAMPLE; sr += G) {
            const u32x2* sp = SL8 + (size_t)sr * (DM / 4) + tid; f32x4 a = {0.f, 0.f, 0.f, 0.f}, c = a;
#pragma unroll
            for (int k = 0; k < 8; ++k) { const u32x2 wa = sp[(size_t)k * (NSAMPLE * DM / 4)], wc = sp[(size_t)(8 + k) * (NSAMPLE * DM / 4)];
                a += (f32x4){pg8::bf_lo(wa.x), pg8::bf_hi(wa.x), pg8::bf_lo(wa.y), pg8::bf_hi(wa.y)}; c += (f32x4){pg8::bf_lo(wc.x), pg8::bf_hi(wc.x), pg8::bf_lo(wc.y), pg8::bf_hi(wc.y)}; }
            const bf16_t* gp = Gt + (size_t)(NPROMPT + sr) * 4096 + tid * 4; const u32x2 gs = *(const u32x2*)gp, gm = *(const u32x2*)(gp + 2048);
            const f32x4 g0 = {pg8::bf_lo(gs.x), pg8::bf_hi(gs.x), pg8::bf_lo(gs.y), pg8::bf_hi(gs.y)}, g1 = {pg8::bf_lo(gm.x), pg8::bf_hi(gm.x), pg8::bf_lo(gm.y), pg8::bf_hi(gm.y)};
            const f32x4 o = g0 * a + g1 * c; u32x2 w; w.x = pk2(o[0], o[1]); w.y = pk2(o[2], o[3]);
            *(u32x2*)(MG + (size_t)(NPROMPT + sr) * DM + tid * 4) = w; }
    }
    SEAM(9);
    if (IN(10)) { pg8::Gemm g{MG, WO, MTOK, DM, DM}; pg8::SplitOrder S; S.init(DM, G, bx, g.K); pg8::EpiResidB E{HB, Y, ALPHA, 1.f, SLAB};
        pg8::gemm_phase<pg8::EpiResidB, pg8::SplitOrder, true, true>(lds, g, S, E); }
    SEAM(10);
    if (IN(11)) ln_phase<pg8::split_nch(DM), true>(lds, Y, args.in[19], args.in[20], nullptr, nullptr, HB, SLAB, HB + (size_t)NPROMPT * DM, ALPHA, 1.f, bx, G, tid, wave, lane);
    SEAM(11);
    if (IN(12)) { pg8::Gemm g{HB, W2I, MTOK, 2 * FF, DM}; pg8::StaticOrder S; S.init(MTOK, 2 * FF, G, bx, g.K); pg8::EpiSwiGLU E{ACT, FF};
        pg8::gemm_phase<pg8::EpiSwiGLU, pg8::StaticOrder, true, true>(lds, g, S, E);
        constexpr int R12 = (MTOK / 256) * (2 * FF / 256) % 256;
        if (G == 256 ? bx >= R12 : true) { const int fw = (G == 256 ? (bx - R12) : bx) * NWAVES + wave, FNW = (G == 256 ? (256 - R12) : G) * NWAVES; LAS float* scr = (LAS float*)(lds + wave * 16384);
            transpose_matrix<0>(args.in[22], FF, DM, W2O, scr, fw, FNW, lane); } }
    SEAM(12);
    if (IN(13)) { pg8::Gemm g{ACT, W2O, MTOK, DM, FF}; pg8::SplitOrder S; S.init(DM, G, bx, g.K); pg8::EpiResidB E{HB, Y, ALPHA, 0.5f, SLAB};
        pg8::gemm_phase<pg8::EpiResidB, pg8::SplitOrder, true, true>(lds, g, S, E); }
    SEAM(13);
    if (IN(14)) ln_phase<pg8::split_nch(FF), true>(lds, Y, args.in[23], args.in[24], out + O_YP, out + O_YS, nullptr, SLAB, HB + (size_t)NPROMPT * DM, ALPHA, 0.5f, bx, G, tid, wave, lane);
#undef IN
#undef SEAM
    if (N_LAUNCHES == 1) {
        __syncthreads();
        if (tid == 0) MISC[12] = (xb_add(&g_bar[GB_DONE], 1u) == (unsigned)G - 1u) ? 1u : 0u;
        __syncthreads();
        if (MISC[12]) { for (int i = tid; i < XCD_BAR_WORDS + 64; i += NWAVES * 64) __hip_atomic_store(&g_bar[i], 0u, __ATOMIC_RELAXED, __HIP_MEMORY_SCOPE_AGENT); }
    }
}

extern "C" void kernel_launch(void* const* d_in, const int* in_sizes, int n_in, void* d_out, int out_size, void* d_ws, size_t ws_size, hipStream_t stream) {
    static int grid = 0;
    if (grid == 0) {
        if (n_in != 25 || out_size != (int)O_END || ws_size < WS_END) { fprintf(stderr, "kernel_launch: expected 25 inputs, %zu outputs, >= %zu B workspace; got %d, %d, %zu\n", (size_t)O_END, (size_t)WS_END, n_in, out_size, ws_size); grid = -1; return; }
        int dev = 0, cus = 0, per_cu = 0;
        if (hipGetDevice(&dev) != hipSuccess || hipDeviceGetAttribute(&cus, hipDeviceAttributeMultiprocessorCount, dev) != hipSuccess) { grid = -1; return; }
        if (hipFuncSetAttribute((const void*)fwd_kernel, hipFuncAttributeMaxDynamicSharedMemorySize, LDS_BYTES) != hipSuccess) { fprintf(stderr, "kernel_launch: hipFuncSetAttribute failed\n"); grid = -1; return; }
        if (hipOccupancyMaxActiveBlocksPerMultiprocessor(&per_cu, (const void*)fwd_kernel, NWAVES * 64, LDS_BYTES) != hipSuccess || per_cu < 1) fprintf(stderr, "kernel_launch: occupancy query says %d\n", per_cu);
        (void)hipGetLastError();
        grid = cus;
        if (grid != 256) { fprintf(stderr, "kernel_launch: built for a 256-CU device (the split-K order deals exactly 256 prompt tiles), found %d CUs; nothing launched\n", cus); grid = -1; return; }
    }
    if (grid < 0) return;
    Args a{};
    for (int i = 0; i < 25; ++i) a.in[i] = (const float*)d_in[i];
    a.out = (float*)d_out; a.ws = (unsigned char*)d_ws;
    for (int li = 0; li < N_LAUNCHES; ++li) {
        a.ph_lo = (N_LAUNCHES == 1) ? 0 : li; a.ph_hi = (N_LAUNCHES == 1) ? NPHASE : li + 1;
        hipLaunchKernelGGL(fwd_kernel, dim3(grid), dim3(NWAVES * 64), LDS_BYTES, stream, a);
        const hipError_t le = hipPeekAtLastError();
        if (le != hipSuccess) { fprintf(stderr, "kernel_launch: launch %d failed: %s\n", li, hipGetErrorName(le)); break; }
    }
}
```

```cpp
#include <hip/hip_runtime.h>
#include <cstdio>
#include <cstdint>
#include <cmath>
constexpr int DM = 2048, NPROMPT = 8192, NSAMPLE = 256, MTOK = NPROMPT + NSAMPLE;
constexpr int SEQ = 4096, DEC_B = 16, DEC_T = 16, PAST = 1024, KEYS_S = PAST + DEC_T;
constexpr int FF = 5504, NIN = 8448;
constexpr int KROWS = NPROMPT + DEC_B * KEYS_S;
constexpr int VPITCH = KROWS + 64;
constexpr float LN_EPS = 1e-5f, RMS_EPS = 1e-6f;
constexpr float ALPHA = 1.18920711500272f;
constexpr float LOG2E = 1.4426950408889634f;
constexpr float SBQ_SCALE = 0.08838834764831845f * LOG2E;
constexpr float MLAQ_SCALE = 0.07216878364870323f * LOG2E;
namespace pg8 {
#define PG8_LAS __attribute__((address_space(3)))
typedef unsigned short bf16_t;
typedef short bf16x8 __attribute__((ext_vector_type(8)));
typedef float f32x4 __attribute__((ext_vector_type(4)));
typedef unsigned u32x4 __attribute__((ext_vector_type(4)));
constexpr int BM = 256, BK = 64, HALF = 128, HTB = HALF * BK * 2  , STAGE_BYTES = 8 * HTB, NXCD = 8, WGM = 8;

__host__ __device__ __forceinline__ int lds_byte(int r, int c) { const int st = (r >> 4) * 2 + (c >> 5), rr = r & 15, cc = c & 31, ob = rr * 64 + cc * 2; return st * 1024 + (ob ^ (((ob >> 9) & 1) << 5)); }
__host__ __device__ __forceinline__ void stage_rc(int b, int& R, int& C) { const int st = b / 1024, sb = b % 1024, swz = sb ^ (((sb >> 9) & 1) << 5); R = (st >> 1) * 16 + swz / 64; C = (st & 1) * 32 + (swz % 64) / 2; }
__host__ __device__ __forceinline__ int perm32(int rho) { const int n = rho >> 4, i = rho & 15; return 8 * (i >> 2) + 4 * n + (i & 3); }

struct Unit { int pm, pn, kofs, nt, chunk, gid; };
struct Gemm { const bf16_t* A; const bf16_t* Bt; int M, N, K; long dA1 = 0, dB1 = 0; };

struct StaticOrder {
    int nM, nN, nwg, G, c, ntf;
    __host__ __device__ void init(int M, int N, int G_, int c_, int K_) { nM = M / BM; nN = N / BM; nwg = nM * nN; G = G_; c = c_; ntf = K_ / BK; }
    __host__ __device__ bool next(int i, Unit& u) const {
        const long L = (long)i * G + c; if (L >= nwg) return false;
        int wgid = (int)L; { const int q = nwg / NXCD, r = nwg % NXCD, xcd = wgid % NXCD, off = wgid / NXCD; wgid = (xcd < r ? xcd * (q + 1) : r * (q + 1) + (xcd - r) * q) + off; }
        const int nig = WGM * nN, gid = wgid / nig, fm = gid * WGM, gsz = (nM - fm) < WGM ? (nM - fm) : WGM;
        u.pm = fm + ((wgid % nig) % gsz); u.pn = (wgid % nig) / gsz; u.kofs = 0; u.nt = ntf; u.chunk = -1; u.gid = 0; return true;
    }
    __device__ __forceinline__ void a_ready(const Unit&) const {}
    __device__ __forceinline__ void done(const Unit&) const {}
};

struct SplitOrder {
    StaticOrder P; int nch, base, extra, c;
    __host__ __device__ void init(int N, int G_, int c_, int K_, int coff = 0) { P.init(NPROMPT, N, G_, c_, K_); const int np = K_ / (2 * BK); nch = np < 16 ? np : 16; base = np / nch; extra = np % nch; c = c_ - coff; }
    __host__ __device__ bool next(int i, Unit& u) const {
        if (i == 0) return P.next(0, u);
        if (i > 1 || c < 0 || c >= 8 * nch) return false;
        const int j = c >> 3; u.gid = 0; u.pm = NPROMPT / BM; u.pn = c & 7; u.chunk = j; u.nt = 2 * (base + (j < extra ? 1 : 0)); u.kofs = 2 * BK * (j * base + (j < extra ? j : extra)); return true;
    }
    __device__ __forceinline__ void a_ready(const Unit&) const {}
    __device__ __forceinline__ void done(const Unit&) const {}
};
struct SplitOrder2 {
    int pm, pn, ntf, cpn, cchunk, cnt, ckofs, cgid; bool has;
    __host__ __device__ void init(int N, int G_, int c_, int K_) {
        SplitOrder T; T.init(N, G_, c_, K_, 0); Unit u; T.next(0, u); pm = u.pm; pn = u.pn; ntf = u.nt;
        cgid = c_ >= 64 ? 1 : 0; SplitOrder C; C.init(N, G_, c_, K_, cgid ? 64 : 0); has = C.next(1, u); cpn = u.pn; cchunk = u.chunk; cnt = u.nt; ckofs = u.kofs;
    }
    __host__ __device__ bool next(int i, Unit& u) const {
        if (i > 2 || (i == 2 && !has)) return false;
        const bool p = i < 2;
        u.pm = p ? pm : NPROMPT / BM; u.pn = p ? pn : cpn; u.chunk = p ? -1 : cchunk; u.nt = p ? ntf : cnt; u.kofs = p ? 0 : ckofs; u.gid = p ? i : cgid; return true;
    }
    __device__ __forceinline__ void a_ready(const Unit&) const {}
    __device__ __forceinline__ void done(const Unit&) const {}
};
constexpr int split_nch(int K_) { return (K_ / 128) < 16 ? (K_ / 128) : 16; }

__device__ __forceinline__ unsigned cvt_pk_bf16(float lo, float hi) { unsigned r; asm volatile("v_cvt_pk_bf16_f32 %0, %1, %2" : "=v"(r) : "v"(lo), "v"(hi)); return r; }
typedef float f32x2 __attribute__((ext_vector_type(2)));
typedef float f32x2_t __attribute__((ext_vector_type(2))); typedef __bf16 bf16x2_t __attribute__((ext_vector_type(2)));
__device__ __forceinline__ unsigned pk2(float lo, float hi) { f32x2_t v = {lo, hi}; bf16x2_t b = __builtin_convertvector(v, bf16x2_t); return __builtin_bit_cast(unsigned, b); }
__device__ __forceinline__ u32x4 pk8(const f32x4 a, const f32x4 b) { u32x4 w; w.x = pk2(a[0], a[1]); w.y = pk2(a[2], a[3]); w.z = pk2(b[0], b[1]); w.w = pk2(b[2], b[3]); return w; }
__device__ __forceinline__ float bf_lo(unsigned w) { return __builtin_bit_cast(float, w << 16); }
__device__ __forceinline__ float bf_hi(unsigned w) { return __builtin_bit_cast(float, w & 0xffff0000u); }
__device__ __forceinline__ void unpk8(const u32x4 w, f32x4& a, f32x4& b) { a = (f32x4){bf_lo(w.x), bf_hi(w.x), bf_lo(w.y), bf_hi(w.y)}; b = (f32x4){bf_lo(w.z), bf_hi(w.z), bf_lo(w.w), bf_hi(w.w)}; }
__device__ __forceinline__ float silu_f(float x) { return x * __builtin_amdgcn_rcpf(1.f + __builtin_amdgcn_exp2f(-1.4426950408889634f * x)); }
__device__ __forceinline__ float sigmoid_f(float x) { return __builtin_amdgcn_rcpf(1.f + __builtin_amdgcn_exp2f(-1.4426950408889634f * x)); }

#define EPI_LOOP_AM _Pragma("unroll") for (int ai = 0; ai < 2; ++ai) _Pragma("unroll") for (int m = 0; m < 4; ++m)

struct EpiSwiGLU {
    static constexpr bool PERM = true, AFTER_DRAIN = false, CHAIN = false;
    bf16_t* O; int ldc;
    __device__ __forceinline__ void operator()(const f32x4 (&acc)[2][2][4][2], const Unit& u, int wr, int wc, int fr, int fq) const {
        const int row0 = u.pm * BM + wr * 64 + fr, col0 = u.pn * 128 + wc * 32 + 8 * fq;
        EPI_LOOP_AM { bf16_t* p = O + (size_t)(row0 + ai * HALF + m * 16) * ldc + col0;
            f32x4 a, b;
#pragma unroll
            for (int e = 0; e < 4; ++e) { a[e] = silu_f(acc[ai][0][m][0][e]) * acc[ai][1][m][0][e]; b[e] = silu_f(acc[ai][0][m][1][e]) * acc[ai][1][m][1][e]; }
            *(u32x4*)p = pk8(a, b); }
    }
};
struct EpiPlain {
    static constexpr bool PERM = true, AFTER_DRAIN = false, CHAIN = false;
    bf16_t* O; int ldc;
    __device__ __forceinline__ void operator()(const f32x4 (&acc)[2][2][4][2], const Unit& u, int wr, int wc, int fr, int fq) const {
        const int row0 = u.pm * BM + wr * 64 + fr, col0 = u.pn * BM + wc * 32 + 8 * fq;
        EPI_LOOP_AM { bf16_t* p = O + (size_t)(row0 + ai * HALF + m * 16) * ldc + col0;
#pragma unroll
            for (int bj = 0; bj < 2; ++bj) *(u32x4*)(p + bj * HALF) = pk8(acc[ai][bj][m][0], acc[ai][bj][m][1]); }
    }
};
struct EpiResid {
    static constexpr bool PERM = true, AFTER_DRAIN = false, CHAIN = false;
    const float* R0; const float* R1; bf16_t* Y; float alpha, s; bf16_t* slab;
    __device__ __forceinline__ void operator()(const f32x4 (&acc)[2][2][4][2], const Unit& u, int wr, int wc, int fr, int fq) const {
        const int row0 = u.pm * BM + wr * 64 + fr, col0 = u.pn * BM + wc * 32 + 8 * fq;
        const bool part = u.chunk >= 0;
        const float al = part ? 0.f : alpha, sc = part ? 1.f : s;
        const float* Rb = (u.pm < NPROMPT / BM) ? R0 + (size_t)row0 * DM : R1 + (size_t)(row0 - NPROMPT) * DM;
        bf16_t* Yb = part ? slab + ((size_t)u.chunk * NSAMPLE + (row0 - NPROMPT)) * DM : Y + (size_t)row0 * DM;
#pragma unroll
        for (int ai = 0; ai < 2; ++ai) {
            f32x4 rv[4][2][2];
#pragma unroll
            for (int m = 0; m < 4; ++m)
#pragma unroll
                for (int bj = 0; bj < 2; ++bj) { const float* rp = Rb + (size_t)(ai * HALF + m * 16) * DM + col0 + bj * HALF; rv[m][bj][0] = *(const f32x4*)rp; rv[m][bj][1] = *(const f32x4*)(rp + 4); }
#pragma unroll
            for (int m = 0; m < 4; ++m)
#pragma unroll
                for (int bj = 0; bj < 2; ++bj) { const size_t ro = (size_t)(ai * HALF + m * 16) * DM + col0 + bj * HALF;
                    const f32x4 y0 = rv[m][bj][0] * al + acc[ai][bj][m][0] * sc, y1 = rv[m][bj][1] * al + acc[ai][bj][m][1] * sc;
                    *(u32x4*)(Yb + ro) = pk8(y0, y1); }
        }
    }
};
struct EpiResidB {
    static constexpr bool PERM = true, AFTER_DRAIN = false, CHAIN = false;
    const bf16_t* RB; bf16_t* Y; float alpha, s; bf16_t* slab;
    __device__ __forceinline__ void operator()(const f32x4 (&acc)[2][2][4][2], const Unit& u, int wr, int wc, int fr, int fq) const {
        const int row0 = u.pm * BM + wr * 64 + fr, col0 = u.pn * BM + wc * 32 + 8 * fq;
        const bool part = u.chunk >= 0;
        const float al = part ? 0.f : alpha, sc = part ? 1.f : s;
        const bf16_t* Rb = RB + (size_t)row0 * DM;
        bf16_t* Yb = part ? slab + ((size_t)u.chunk * NSAMPLE + (row0 - NPROMPT)) * DM : Y + (size_t)row0 * DM;
#pragma unroll
        for (int ai = 0; ai < 2; ++ai) {
            u32x4 rv[4][2];
#pragma unroll
            for (int m = 0; m < 4; ++m)
#pragma unroll
                for (int bj = 0; bj < 2; ++bj) rv[m][bj] = *(const u32x4*)(Rb + (size_t)(ai * HALF + m * 16) * DM + col0 + bj * HALF);
#pragma unroll
            for (int m = 0; m < 4; ++m)
#pragma unroll
                for (int bj = 0; bj < 2; ++bj) { const size_t ro = (size_t)(ai * HALF + m * 16) * DM + col0 + bj * HALF; f32x4 r0, r1; unpk8(rv[m][bj], r0, r1);
                    const f32x4 y0 = r0 * al + acc[ai][bj][m][0] * sc, y1 = r1 * al + acc[ai][bj][m][1] * sc;
                    *(u32x4*)(Yb + ro) = pk8(y0, y1); }
        }
    }
};
struct EpiWin {
    static constexpr bool PERM = true, AFTER_DRAIN = false, CHAIN = false;
    bf16_t* QS; float* out; float* CQ; float* KR; bf16_t* G; const float* bgate; float qscale;
    __device__ __forceinline__ void operator()(const f32x4 (&acc)[2][2][4][2], const Unit& u, int wr, int wc, int fr, int fq) const {
        const int row0 = u.pm * BM + wr * 64 + fr, colt = wc * 32 + 8 * fq; const int pn = u.pn;
        if (pn < 4) {
            EPI_LOOP_AM { bf16_t* p = QS + (size_t)(row0 + ai * HALF + m * 16) * 1024 + pn * BM + colt;
#pragma unroll
                for (int bj = 0; bj < 2; ++bj) *(u32x4*)(p + bj * HALF) = pk8(acc[ai][bj][m][0] * qscale, acc[ai][bj][m][1] * qscale); }
        } else if (pn < 12) {
            const bool isk = pn < 8; const bool smp = u.pm >= NPROMPT / BM;
            size_t off = isk ? (size_t)17301504 : (size_t)25690112;
            if (smp) off = isk ? (size_t)38797312 : (size_t)39059456;
            const int rr = smp ? row0 - NPROMPT : row0; const int cc = (pn - (isk ? 4 : 8)) * BM + colt;
            EPI_LOOP_AM { float* p = out + off + (size_t)(rr + ai * HALF + m * 16) * 1024 + cc;
#pragma unroll
                for (int bj = 0; bj < 2; ++bj) { *(f32x4*)(p + bj * HALF) = acc[ai][bj][m][0]; *(f32x4*)(p + bj * HALF + 4) = acc[ai][bj][m][1]; } }
        } else if (pn < 16) {
            const size_t off = (pn < 14 ? (size_t)0 : (size_t)MTOK * 512); const int cc = (pn & 1) * BM + colt;
            EPI_LOOP_AM { float* p = CQ + off + (size_t)(row0 + ai * HALF + m * 16) * 512 + cc;
#pragma unroll
                for (int bj = 0; bj < 2; ++bj) { *(f32x4*)(p + bj * HALF) = acc[ai][bj][m][0]; *(f32x4*)(p + bj * HALF + 4) = acc[ai][bj][m][1]; } }
        } else if (pn < 32) {
            const int cc = (pn - 16) * BM + colt;
            f32x4 bg[2][2];
#pragma unroll
            for (int bj = 0; bj < 2; ++bj) { bg[bj][0] = *(const f32x4*)(bgate + cc + bj * HALF); bg[bj][1] = *(const f32x4*)(bgate + cc + bj * HALF + 4); }
            EPI_LOOP_AM { bf16_t* p = G + (size_t)(row0 + ai * HALF + m * 16) * 4096 + cc;
#pragma unroll
                for (int bj = 0; bj < 2; ++bj) { f32x4 a = acc[ai][bj][m][0] + bg[bj][0], b = acc[ai][bj][m][1] + bg[bj][1];
#pragma unroll
                    for (int e = 0; e < 4; ++e) { a[e] = sigmoid_f(a[e]); b[e] = sigmoid_f(b[e]); }
                    *(u32x4*)(p + bj * HALF) = pk8(a, b); } }
        } else {
            if (wc < 2) { EPI_LOOP_AM { float* p = KR + (size_t)(row0 + ai * HALF + m * 16) * 64 + colt; *(f32x4*)p = acc[ai][0][m][0]; *(f32x4*)(p + 4) = acc[ai][0][m][1]; } }
        }
    }
};
struct EpiUq {
    static constexpr bool PERM = true, AFTER_DRAIN = false, CHAIN = false;
    bf16_t* QM; const float* tab; float scale;
    __device__ __forceinline__ void operator()(const f32x4 (&acc)[2][2][4][2], const Unit& u, int wr, int wc, int fr, int fq) const {
        const int row0 = u.pm * BM + wr * 64 + fr, col0 = u.pn * BM + wc * 32 + 8 * fq;
        EPI_LOOP_AM { const int row = row0 + ai * HALF + m * 16; const int pos = row < NPROMPT ? (row & 4095) : 1024 + ((row - NPROMPT) & 15);
            bf16_t* p = QM + (size_t)row * 1536 + col0;
#pragma unroll
            for (int bj = 0; bj < 2; ++bj) { const int col = col0 + bj * HALF; const int hc = col % 192; f32x4 a = acc[ai][bj][m][0], b = acc[ai][bj][m][1];
                if (hc >= 128) { const float* t = tab + (size_t)pos * 64 + (hc - 128);
                    const f32x4 t0 = *(const f32x4*)t, t1 = *(const f32x4*)(t + 4);
                    const f32x4 a2 = {a[0] * t0[0] - a[1] * t0[1], a[1] * t0[0] + a[0] * t0[1], a[2] * t0[2] - a[3] * t0[3], a[3] * t0[2] + a[2] * t0[3]};
                    const f32x4 b2 = {b[0] * t1[0] - b[1] * t1[1], b[1] * t1[0] + b[0] * t1[1], b[2] * t1[2] - b[3] * t1[3], b[3] * t1[2] + b[2] * t1[3]};
                    a = a2; b = b2; }
                *(u32x4*)(p + bj * HALF) = pk8(a * scale, b * scale); } }
    }
};
struct EpiChainBr {
    static constexpr bool PERM = true, AFTER_DRAIN = false, CHAIN = true;
    const bf16_t* G; bf16_t* MG; bf16_t* slab;
    __device__ __forceinline__ void chain(f32x4 (&acc)[2][2][4][2], const Unit& u, int wr, int wc, int fr, int fq) const {
        const int row0 = u.pm * BM + wr * 64 + fr, col0 = u.pn * BM + wc * 32 + 8 * fq;
        const bf16_t* gb = G + (size_t)row0 * 4096 + col0;
#pragma unroll
        for (int ai = 0; ai < 2; ++ai)
#pragma unroll
            for (int m = 0; m < 4; ++m) {
                u32x4 gs[2], gm[2];
#pragma unroll
                for (int bj = 0; bj < 2; ++bj) { const bf16_t* gp = gb + (size_t)(ai * HALF + m * 16) * 4096 + bj * HALF; gs[bj] = *(const u32x4*)gp; gm[bj] = *(const u32x4*)(gp + 2048); }
#pragma unroll
                for (int bj = 0; bj < 2; ++bj) { f32x4 s0, s1, m0, m1; unpk8(gs[bj], s0, s1); unpk8(gm[bj], m0, m1);
#pragma unroll
                    for (int e = 0; e < 4; ++e) { acc[ai][bj][m][0][e] *= s0[e] * __builtin_amdgcn_rcpf(fmaxf(m0[e], 1e-20f)); acc[ai][bj][m][1][e] *= s1[e] * __builtin_amdgcn_rcpf(fmaxf(m1[e], 1e-20f)); } }
            }
    }
    __device__ __forceinline__ void operator()(const f32x4 (&acc)[2][2][4][2], const Unit& u, int wr, int wc, int fr, int fq) const {
        const int row0 = u.pm * BM + wr * 64 + fr, col0 = u.pn * BM + wc * 32 + 8 * fq;
        if (u.chunk >= 0) { bf16_t* sp = slab + ((size_t)(u.chunk + 8 * u.gid) * NSAMPLE + (row0 - NPROMPT)) * DM + col0;
            EPI_LOOP_AM {
#pragma unroll
                for (int bj = 0; bj < 2; ++bj) *(u32x4*)(sp + (size_t)(ai * HALF + m * 16) * DM + bj * HALF) = pk8(acc[ai][bj][m][0], acc[ai][bj][m][1]); }
        } else {
#pragma unroll
            for (int ai = 0; ai < 2; ++ai)
#pragma unroll
                for (int mh = 0; mh < 2; ++mh) {
                    u32x4 gm[2][2];
#pragma unroll
                    for (int mm = 0; mm < 2; ++mm)
#pragma unroll
                        for (int bj = 0; bj < 2; ++bj) gm[mm][bj] = *(const u32x4*)(G + (size_t)(row0 + ai * HALF + (2 * mh + mm) * 16) * 4096 + 2048 + col0 + bj * HALF);
#pragma unroll
                    for (int mm = 0; mm < 2; ++mm)
#pragma unroll
                        for (int bj = 0; bj < 2; ++bj) { const int m = 2 * mh + mm; f32x4 m0, m1; unpk8(gm[mm][bj], m0, m1);
#pragma unroll
                            for (int e = 0; e < 4; ++e) { m0[e] = fmaxf(m0[e], 1e-20f); m1[e] = fmaxf(m1[e], 1e-20f); }
                            *(u32x4*)(MG + (size_t)(row0 + ai * HALF + m * 16) * DM + col0 + bj * HALF) = pk8(acc[ai][bj][m][0] * m0, acc[ai][bj][m][1] * m1); }
                }
        }
    }
};
struct EpiBrSb {
    static constexpr bool PERM = true, AFTER_DRAIN = false, CHAIN = false;
    float* T; const bf16_t* G; bf16_t* slab;
    __device__ __forceinline__ void operator()(const f32x4 (&acc)[2][2][4][2], const Unit& u, int wr, int wc, int fr, int fq) const {
        const int row0 = u.pm * BM + wr * 64 + fr, col0 = u.pn * BM + wc * 32 + 8 * fq; const bool part = u.chunk >= 0;
        if (part) { bf16_t* sp = slab + ((size_t)u.chunk * NSAMPLE + (row0 - NPROMPT)) * DM + col0;
            EPI_LOOP_AM {
#pragma unroll
                for (int bj = 0; bj < 2; ++bj) *(u32x4*)(sp + (size_t)(ai * HALF + m * 16) * DM + bj * HALF) = pk8(acc[ai][bj][m][0], acc[ai][bj][m][1]); }
        } else {
#pragma unroll
        for (int ai = 0; ai < 2; ++ai) {
            u32x4 gv[4][2];
#pragma unroll
            for (int m = 0; m < 4; ++m)
#pragma unroll
                for (int bj = 0; bj < 2; ++bj) gv[m][bj] = *(const u32x4*)(G + (size_t)(row0 + ai * HALF + m * 16) * 4096 + col0 + bj * HALF);
#pragma unroll
            for (int m = 0; m < 4; ++m)
#pragma unroll
                for (int bj = 0; bj < 2; ++bj) { f32x4 g0, g1; unpk8(gv[m][bj], g0, g1);
                    float* tp = T + (size_t)(row0 + ai * HALF + m * 16) * DM + col0 + bj * HALF; *(f32x4*)tp = g0 * acc[ai][bj][m][0]; *(f32x4*)(tp + 4) = g1 * acc[ai][bj][m][1]; }
        } }
    }
};
struct EpiBrMla {
    static constexpr bool PERM = true, AFTER_DRAIN = false, CHAIN = false;
    const float* T; const bf16_t* G; bf16_t* MG; bf16_t* slab;
    __device__ __forceinline__ void operator()(const f32x4 (&acc)[2][2][4][2], const Unit& u, int wr, int wc, int fr, int fq) const {
        const int row0 = u.pm * BM + wr * 64 + fr, col0 = u.pn * BM + wc * 32 + 8 * fq;
        if (u.chunk >= 0) { bf16_t* sp = slab + ((size_t)u.chunk * NSAMPLE + (row0 - NPROMPT)) * DM + col0;
            EPI_LOOP_AM {
#pragma unroll
                for (int bj = 0; bj < 2; ++bj) *(u32x4*)(sp + (size_t)(ai * HALF + m * 16) * DM + bj * HALF) = pk8(acc[ai][bj][m][0], acc[ai][bj][m][1]); }
        } else {
#pragma unroll
            for (int ai = 0; ai < 2; ++ai)
#pragma unroll
                for (int mh = 0; mh < 2; ++mh) {
                    u32x4 gv[2][2]; f32x4 tv[2][2][2];
#pragma unroll
                    for (int mm = 0; mm < 2; ++mm)
#pragma unroll
                        for (int bj = 0; bj < 2; ++bj) { const int row = row0 + ai * HALF + (2 * mh + mm) * 16; gv[mm][bj] = *(const u32x4*)(G + (size_t)row * 4096 + 2048 + col0 + bj * HALF);
                            const float* tp = T + (size_t)row * DM + col0 + bj * HALF; tv[mm][bj][0] = *(const f32x4*)tp; tv[mm][bj][1] = *(const f32x4*)(tp + 4); }
#pragma unroll
                    for (int mm = 0; mm < 2; ++mm)
#pragma unroll
                        for (int bj = 0; bj < 2; ++bj) { const int m = 2 * mh + mm; f32x4 g0, g1; unpk8(gv[mm][bj], g0, g1);
                            *(u32x4*)(MG + (size_t)(row0 + ai * HALF + m * 16) * DM + col0 + bj * HALF) = pk8(tv[mm][bj][0] + g0 * acc[ai][bj][m][0], tv[mm][bj][1] + g1 * acc[ai][bj][m][1]); }
                }
        }
    }
};
template <class Epi, class Sched, bool ALIGN_EPI = false, bool SP2 = false>
__device__ __forceinline__ void gemm_phase(PG8_LAS unsigned char* lds, const Gemm g, const Sched& S, const Epi& E) {
    const int tid = threadIdx.x, wid = __builtin_amdgcn_readfirstlane(tid >> 6), lane = tid & 63, wr = wid >> 2, wc = wid & 3, fr = lane & 15, fq = lane >> 4;
    const int K = g.K;
    unsigned voffA[2], voffB[2];
#pragma unroll
    for (int i = 0; i < 2; ++i) { int R, C; stage_rc(tid * 16 + i * 8192, R, C); const int Rb = Epi::PERM ? ((R & ~31) + perm32(R & 31)) : R;
        voffA[i] = (unsigned)(R * K + C) * 2u; voffB[i] = (unsigned)(Rb * K + C) * 2u; }
    const size_t kstep = (size_t)(BK * 2);
    const size_t hstep = (size_t)HALF * K * 2;
    const size_t tstep = 2 * hstep;
    const unsigned ldsw = (unsigned)wid * 1024u;
    const int aoff = lds_byte(wr * 64 + fr, fq * 8), boff = lds_byte(wc * 32 + fr, fq * 8);
#define PG8_SA(b, h) (((b) * 2 + (h)) * HTB)
#define PG8_SB(b, h) ((4 + (b) * 2 + (h)) * HTB)
#define PG8_STAGE(bufoff, gbase, voff) do { _Pragma("unroll") for (int _i = 0; _i < 2; ++_i) \
        __builtin_amdgcn_global_load_lds((const unsigned*)((const char*)(gbase) + (voff)[_i]), (PG8_LAS unsigned*)(lds + (bufoff) + ldsw + _i * 8192), 16, 0, 0); } while (0)
#define PG8_LDA(dst, b, h) do { _Pragma("unroll") for (int m = 0; m < 4; ++m) _Pragma("unroll") for (int k = 0; k < 2; ++k) dst[m][k] = *(const PG8_LAS bf16x8*)(lds + PG8_SA(b, h) + aoff + m * 2048 + k * 1024); } while (0)
#define PG8_LDB(dst, b, h) do { _Pragma("unroll") for (int n = 0; n < 2; ++n) _Pragma("unroll") for (int k = 0; k < 2; ++k) dst[n][k] = *(const PG8_LAS bf16x8*)(lds + PG8_SB(b, h) + boff + n * 2048 + k * 1024); } while (0)
#define PG8_MMA(ai, bj, At, Bt) do { __builtin_amdgcn_s_setprio(1); _Pragma("unroll") for (int m = 0; m < 4; ++m) _Pragma("unroll") for (int n = 0; n < 2; ++n) _Pragma("unroll") for (int k = 0; k < 2; ++k) \
        acc[ai][bj][m][n] = __builtin_amdgcn_mfma_f32_16x16x32_bf16(Bt[n][k], At[m][k], acc[ai][bj][m][n], 0, 0, 0); __builtin_amdgcn_s_setprio(0); } while (0)
#define PG8_WAIT_V(n) asm volatile("s_waitcnt vmcnt(" #n ")" ::: "memory")
#define PG8_WAIT_L(n) asm volatile("s_waitcnt lgkmcnt(" #n ")" ::: "memory")
#define PG8_BAR __builtin_amdgcn_s_barrier()
#define PG8_SCHED __builtin_amdgcn_sched_barrier(0)
    Unit cur, nxt; int ui = 0;
    if (!S.next(0, cur)) return;
    f32x4 acc[2][2][4][2];
#pragma unroll
    for (int a = 0; a < 2; ++a)
#pragma unroll
        for (int b = 0; b < 2; ++b)
#pragma unroll
            for (int m = 0; m < 4; ++m)
#pragma unroll
                for (int n = 0; n < 2; ++n) acc[a][b][m][n] = (f32x4){0.f, 0.f, 0.f, 0.f};
    bf16x8 At[4][2], B0[2][2], B1[2][2];
#define PG8_GA(u_) ((const char*)g.A + ((u_).gid == 1 ? g.dA1 : 0L))
#define PG8_GB(u_) ((const char*)g.Bt + ((u_).gid == 1 ? g.dB1 : 0L))
    const char* cA = PG8_GA(cur) + (size_t)cur.pm * tstep + (size_t)cur.kofs * 2; const char* cB = PG8_GB(cur) + (size_t)cur.pn * tstep + (size_t)cur.kofs * 2;
    S.a_ready(cur);
    if constexpr (SP2) {
        PG8_STAGE(PG8_SB(0, 0), cB, voffB); PG8_STAGE(PG8_SB(0, 1), cB + hstep, voffB); PG8_STAGE(PG8_SA(0, 0), cA, voffA); PG8_STAGE(PG8_SA(0, 1), cA + hstep, voffA);
        if (wr == 1) PG8_BAR;
        PG8_WAIT_V(2); PG8_BAR;
        PG8_STAGE(PG8_SB(1, 0), cB + kstep, voffB); PG8_STAGE(PG8_SA(1, 0), cA + kstep, voffA); PG8_STAGE(PG8_SB(1, 1), cB + hstep + kstep, voffB);
        PG8_WAIT_V(6); PG8_BAR;
    } else {
        PG8_STAGE(PG8_SB(0, 0), cB, voffB); PG8_STAGE(PG8_SA(0, 0), cA, voffA); PG8_STAGE(PG8_SB(0, 1), cB + hstep, voffB); PG8_STAGE(PG8_SA(0, 1), cA + hstep, voffA);
        if (wr == 1) PG8_BAR;
        PG8_WAIT_V(4); PG8_BAR;
        PG8_STAGE(PG8_SB(1, 0), cB + kstep, voffB); PG8_STAGE(PG8_SA(1, 0), cA + kstep, voffA); PG8_STAGE(PG8_SB(1, 1), cB + hstep + kstep, voffB);
        PG8_WAIT_V(6); PG8_BAR;
    }
    for (;;) {
        const bool has_next = S.next(ui + 1, nxt);
        const char* nA = has_next ? PG8_GA(nxt) + (size_t)nxt.pm * tstep + (size_t)nxt.kofs * 2 : cA; const char* nB = has_next ? PG8_GB(nxt) + (size_t)nxt.pn * tstep + (size_t)nxt.kofs * 2 : cB;
        const int nt = cur.nt;
        for (int t = 0; t < nt; t += 2) {
            const bool last = (t == nt - 2);
            const char* a1 = cA + (size_t)(t + 1) * kstep;
            const char* a2 = last ? nA : cA + (size_t)(t + 2) * kstep; const char* b2 = last ? nB : cB + (size_t)(t + 2) * kstep;
            const char* a3 = a2 + kstep; const char* b3 = b2 + kstep;
            if (last && has_next) S.a_ready(nxt);
            if constexpr (SP2) {
            PG8_LDB(B0, 0, 0); PG8_LDB(B1, 0, 1); PG8_SCHED; PG8_LDA(At, 0, 0); PG8_STAGE(PG8_SA(1, 1), a1 + hstep, voffA);
            PG8_WAIT_V(8); PG8_WAIT_L(0); PG8_BAR; PG8_MMA(0, 0, At, B0); PG8_MMA(0, 1, At, B1); PG8_BAR; PG8_SCHED;
            PG8_LDA(At, 0, 1); PG8_STAGE(PG8_SB(0, 0), b2, voffB); PG8_STAGE(PG8_SB(0, 1), b2 + hstep, voffB); PG8_STAGE(PG8_SA(0, 0), a2, voffA);
            PG8_WAIT_V(8); PG8_WAIT_L(0); PG8_BAR; PG8_MMA(1, 0, At, B0); PG8_MMA(1, 1, At, B1); PG8_BAR; PG8_SCHED;
            PG8_LDB(B0, 1, 0); PG8_LDB(B1, 1, 1); PG8_SCHED; PG8_LDA(At, 1, 0); PG8_STAGE(PG8_SA(0, 1), a2 + hstep, voffA);
            PG8_WAIT_V(8); PG8_WAIT_L(0); PG8_BAR; PG8_MMA(0, 0, At, B0); PG8_MMA(0, 1, At, B1); PG8_BAR; PG8_SCHED;
            PG8_LDA(At, 1, 1); PG8_STAGE(PG8_SB(1, 0), b3, voffB); PG8_STAGE(PG8_SB(1, 1), b3 + hstep, voffB); PG8_STAGE(PG8_SA(1, 0), a3, voffA);
            PG8_WAIT_V(8); PG8_WAIT_L(0); PG8_BAR; PG8_MMA(1, 0, At, B0); PG8_MMA(1, 1, At, B1); PG8_BAR; PG8_SCHED;
            } else {
            PG8_LDB(B0, 0, 0); PG8_SCHED; PG8_LDA(At, 0, 0); PG8_STAGE(PG8_SA(1, 1), a1 + hstep, voffA);
            PG8_WAIT_L(8); PG8_BAR; PG8_WAIT_L(0); PG8_MMA(0, 0, At, B0); PG8_BAR; PG8_SCHED;
            PG8_LDB(B1, 0, 1); PG8_STAGE(PG8_SB(0, 0), b2, voffB);
            PG8_BAR; PG8_WAIT_L(0); PG8_MMA(0, 1, At, B1); PG8_BAR;
            PG8_LDA(At, 0, 1); PG8_STAGE(PG8_SA(0, 0), a2, voffA);
            PG8_BAR; PG8_WAIT_L(0); PG8_MMA(1, 0, At, B0); PG8_BAR; PG8_SCHED;
            PG8_STAGE(PG8_SB(0, 1), b2 + hstep, voffB);
            PG8_WAIT_V(6); PG8_BAR; PG8_MMA(1, 1, At, B1); PG8_BAR;
            PG8_LDB(B0, 1, 0); PG8_SCHED; PG8_LDA(At, 1, 0); PG8_STAGE(PG8_SA(0, 1), a2 + hstep, voffA);
            PG8_WAIT_L(8); PG8_BAR; PG8_WAIT_L(0); PG8_MMA(0, 0, At, B0); PG8_BAR; PG8_SCHED;
            PG8_LDB(B1, 1, 1); PG8_STAGE(PG8_SB(1, 0), b3, voffB);
            PG8_BAR; PG8_WAIT_L(0); PG8_MMA(0, 1, At, B1); PG8_BAR;
            PG8_LDA(At, 1, 1); PG8_STAGE(PG8_SA(1, 0), a3, voffA);
            PG8_BAR; PG8_WAIT_L(0); PG8_MMA(1, 0, At, B0); PG8_BAR; PG8_SCHED;
            PG8_STAGE(PG8_SB(1, 1), b3 + hstep, voffB);
            PG8_WAIT_V(6); PG8_BAR; PG8_MMA(1, 1, At, B1); PG8_BAR;
            }
        }
        if constexpr (ALIGN_EPI) { if (wr == 0) PG8_BAR; }
        bool chained = false;
        if constexpr (Epi::CHAIN) { if (cur.gid == 0 && cur.chunk < 0) { E.chain(acc, cur, wr, wc, fr, fq); chained = true; } }
        if constexpr (!Epi::AFTER_DRAIN) { if (!chained) { E(acc, cur, wr, wc, fr, fq); S.done(cur); } }
        if (!has_next) break;
        if (!chained)
#pragma unroll
        for (int a = 0; a < 2; ++a)
#pragma unroll
            for (int b = 0; b < 2; ++b)
#pragma unroll
                for (int m = 0; m < 4; ++m)
#pragma unroll
                    for (int n = 0; n < 2; ++n) acc[a][b][m][n] = (f32x4){0.f, 0.f, 0.f, 0.f};
        cur = nxt; cA = nA; cB = nB; ++ui;
        if constexpr (ALIGN_EPI) { if (wr == 1) PG8_BAR; }
    }
    PG8_WAIT_V(0);
    if constexpr (!ALIGN_EPI) { if (wr == 0) PG8_BAR; }
    PG8_BAR;
    if constexpr (Epi::AFTER_DRAIN) { E.fused(acc, cur, wr, wc, fr, fq, lds, wid, lane); S.done(cur); }
#undef PG8_GA
#undef PG8_GB
#undef PG8_SA
#undef PG8_SB
#undef PG8_STAGE
#undef PG8_LDA
#undef PG8_LDB
#undef PG8_MMA
#undef PG8_WAIT_V
#undef PG8_WAIT_L
#undef PG8_BAR
#undef PG8_SCHED
}
}

using pg8::bf16_t; using pg8::bf16x8; using pg8::f32x4; using pg8::u32x4; using pg8::pk2; using pg8::pk8;
typedef float f32x16 __attribute__((ext_vector_type(16)));
typedef unsigned u32x2 __attribute__((ext_vector_type(2)));
constexpr int NWAVES = 8;
#define GAS __attribute__((address_space(1)))
#define LAS __attribute__((address_space(3)))
typedef GAS unsigned gu32;
#define RLX_AGENT __ATOMIC_RELAXED, __HIP_MEMORY_SCOPE_AGENT
#define LDS_WAIT() asm volatile("s_waitcnt lgkmcnt(0)" ::: "memory")
#define VM_WAIT() asm volatile("s_waitcnt vmcnt(0)" ::: "memory")

constexpr size_t MiB = 1u << 20;
constexpr size_t WS_CTL = 0, CTL_ZERO_BYTES = 1 * MiB;
constexpr size_t WS_TAB = 1 * MiB;
constexpr size_t WS_W1I = 2 * MiB;
constexpr size_t WS_W1O = WS_W1I + (size_t)2 * FF * DM * 2;
constexpr size_t WS_KN  = WS_W1I;
constexpr size_t WS_HB  = WS_W1O + (size_t)DM * FF * 2;
constexpr size_t WS_WIN = WS_HB + (size_t)MTOK * DM * 2;
constexpr size_t WS_WUQ = WS_WIN + (size_t)NIN * DM * 2;
constexpr size_t WS_WKV = WS_WUQ + (size_t)1536 * 512 * 2;
constexpr size_t WS_WBS = WS_WKV + (size_t)2048 * 512 * 2;
constexpr size_t WS_WBM = WS_WBS + (size_t)DM * 1024 * 2;
constexpr size_t WS_WO  = WS_WBM + (size_t)DM * 1024 * 2;
constexpr size_t WS_W2I = WS_WO + (size_t)DM * DM * 2;
constexpr size_t WS_W2O = WS_W2I + (size_t)2 * FF * DM * 2;
constexpr size_t WS_ACT = WS_W2O + (size_t)DM * FF * 2;
constexpr size_t WS_G   = WS_ACT;
constexpr size_t WS_Y   = WS_ACT + (size_t)MTOK * FF * 2;
constexpr size_t WS_VT  = WS_Y;
constexpr size_t WS_T   = WS_Y;
constexpr size_t WS_H   = WS_Y + (size_t)MTOK * DM * 4;
constexpr size_t WS_QM  = WS_H;
constexpr size_t WS_QS  = WS_H + (size_t)MTOK * DM * 4;
constexpr size_t WS_CQ  = WS_QS + (size_t)MTOK * 1024 * 2;
constexpr size_t WS_CKV = WS_CQ + (size_t)MTOK * 512 * 4;
constexpr size_t WS_KR  = WS_CKV + (size_t)MTOK * 512 * 4;
constexpr size_t WS_OSB = WS_CQ;
constexpr size_t WS_OML = WS_OSB + (size_t)MTOK * 1024 * 2;
constexpr size_t WS_CKA = WS_KR + (size_t)MTOK * 64 * 4;
constexpr size_t WS_CQB = WS_CKA + (size_t)KROWS * 512 * 2;
constexpr size_t WS_MG  = WS_CKA;
constexpr size_t WS_KRB = WS_CKA + (size_t)MTOK * DM * 2;
constexpr size_t WS_END = WS_KRB + (size_t)NPROMPT * 64 * 2;
static_assert(WS_OML + (size_t)MTOK * 1024 * 2 <= WS_CKA && WS_CQB + (size_t)MTOK * 512 * 2 <= WS_KRB && WS_KN + (size_t)(KROWS + 32) * 1024 * 2 <= WS_HB && WS_VT + (size_t)1024 * VPITCH * 2 <= WS_H, "d_ws map");
static_assert(WS_KN + (size_t)16 * NSAMPLE * DM * 2 <= WS_HB && WS_CQ + (size_t)16 * NSAMPLE * DM * 2 <= WS_CKA, "split-K slabs");
static_assert(WS_END <= (size_t)600 * MiB && (WS_W1O % 256) == 0 && (WS_CKA % 256) == 0 && (WS_CQB % 256) == 0, "d_ws map");
constexpr size_t O_YP = 0, O_YS = 16777216, O_KP = 17301504, O_VP = 25690112, O_CKVP = 34078720, O_KRP = 38273024, O_KS = 38797312, O_VS = 39059456, O_CKVS = 39321600, O_KRS = 39452672, O_END = 39469056;
constexpr int CW_TMO = 0, CW_BAR = 4096;
constexpr int RING_BYTES = 131072, LDSCTL_OFF = RING_BYTES, MISC_OFF = LDSCTL_OFF + 320, LDS_BYTES = 147456;
#define XB_TMO      128
#define XB_XCNT(j)  (256  + 64 * (j))
#define XB_XSUB(j)  (1280 + 64 * (j))
#define XB_XGEN(j)  (2304 + 64 * (j))
#define XB_TOP      3328
#define XB_TOPGEN   3392
#define XCD_BAR_WORDS 3456
#define XB_SPIN_CAP (1u << 18)

__device__ __forceinline__ unsigned xb_ld(unsigned* p)              { return __hip_atomic_load(p, __ATOMIC_RELAXED, __HIP_MEMORY_SCOPE_AGENT); }
__device__ __forceinline__ unsigned xb_add(unsigned* p, unsigned v) { return __hip_atomic_fetch_add(p, v, __ATOMIC_RELAXED, __HIP_MEMORY_SCOPE_AGENT); }
__device__ __forceinline__ unsigned xb_xcc_id() { return (unsigned)__builtin_amdgcn_s_getreg((3 << 11) | 20) & 0xFu; }
#define XB_SPIN(cond, bar) do { unsigned _sp = 0; while (cond) { __builtin_amdgcn_s_sleep(1); \
    if ((++_sp & 255u) == 0u) { if (xb_ld(&(bar)[XB_TMO])) break; if (_sp > XB_SPIN_CAP) { atomicAdd(&(bar)[XB_TMO], 1u); break; } } } } while (0)

struct XcdBarrier {
    unsigned* bar; unsigned x;
    volatile LAS unsigned* st;
};

__device__ __forceinline__ XcdBarrier xcd_barrier_post(unsigned* bar, volatile LAS unsigned* st) {
    XcdBarrier b; b.bar = bar; b.x = xb_xcc_id(); b.st = st;
    if (threadIdx.x == 0) (void)xb_add(&bar[XB_XCNT(b.x)], 1u);
    return b;
}
__device__ __forceinline__ void xcd_barrier_complete(unsigned* bar, unsigned x, unsigned& nloc, unsigned& nx) {
    const unsigned G = gridDim.x * gridDim.y * gridDim.z;
    unsigned sum, cnt, mine, sp = 0u;
    for (;;) {
        sum = 0u; cnt = 0u; mine = 0u;
#pragma unroll
        for (unsigned j = 0; j < 16; ++j) { const unsigned c = xb_ld(&bar[XB_XCNT(j)]); sum += c; cnt += (c > 0u) ? 1u : 0u; mine = (j == x) ? c : mine; }
        if (sum == G) break;
        __builtin_amdgcn_s_sleep(1);
        if ((++sp & 255u) == 0u) { if (xb_ld(&bar[XB_TMO])) break; if (sp > XB_SPIN_CAP) { atomicAdd(&bar[XB_TMO], 1u); break; } }
    }
    nloc = mine > 0u ? mine : 1u; nx = cnt > 0u ? cnt : 1u;
}

__device__ __forceinline__ void xcd_barrier(const XcdBarrier& b) {
    asm volatile("s_waitcnt vmcnt(0)" ::: "memory");
    __syncthreads();
    if (threadIdx.x == 0) {
        unsigned* bar = b.bar;
        __builtin_amdgcn_s_waitcnt(0);
        unsigned nloc = b.st[0], nx = b.st[1];
        if (nloc == 0u) { xcd_barrier_complete(bar, b.x, nloc, nx); b.st[0] = nloc; b.st[1] = nx; }
        const unsigned old = xb_add(&bar[XB_XSUB(b.x)], 1u);
        const unsigned gen = old / nloc;
        if (old + 1u == (gen + 1u) * nloc) {
            __builtin_amdgcn_fence(__ATOMIC_RELEASE, "agent");
            asm volatile("s_waitcnt vmcnt(0)" ::: "memory");
            const unsigned og = xb_add(&bar[XB_TOP], 1u);
            const unsigned tg = og / nx;
            if (og + 1u == (tg + 1u) * nx) xb_add(&bar[XB_TOPGEN], 1u);
            else XB_SPIN(xb_ld(&bar[XB_TOPGEN]) == tg, bar);
            __builtin_amdgcn_fence(__ATOMIC_ACQUIRE, "agent");
            xb_add(&bar[XB_XGEN(b.x)], 1u);
            asm volatile("s_waitcnt vmcnt(0)" ::: "memory");
        } else {
            XB_SPIN(xb_ld(&bar[XB_XGEN(b.x)]) == gen, bar);
            __builtin_amdgcn_fence(__ATOMIC_ACQUIRE, "agent");
            asm volatile("s_waitcnt vmcnt(0)" ::: "memory");
        }
    }
    __syncthreads();
}

__device__ __forceinline__ float wave_sum(float v) {
#pragma unroll
    for (int o = 1; o < 64; o <<= 1) v += __shfl_xor(v, o);
    return v;
}
__device__ __forceinline__ void transpose_item(const float* W, int ldw, int k0, int n0, bf16_t* WT, int ldt, int drow0, LAS float* scr, int lane) {
#pragma unroll 8
    for (int i = 0; i < 32; ++i) { const int kk = 2 * i + (lane >> 5); scr[kk * 33 + (lane & 31)] = W[(size_t)(k0 + kk) * ldw + n0 + (lane & 31)]; }
    LDS_WAIT(); asm volatile("" ::: "memory");
    const int c = lane & 7;
#pragma unroll
    for (int j = 0; j < 4; ++j) { const int n = (lane >> 3) + 8 * j; const LAS float* s = scr + (8 * c) * 33 + n;
        u32x4 o; o.x = pk2(s[0 * 33], s[1 * 33]); o.y = pk2(s[2 * 33], s[3 * 33]); o.z = pk2(s[4 * 33], s[5 * 33]); o.w = pk2(s[6 * 33], s[7 * 33]);
        *(u32x4*)(WT + (size_t)(drow0 + n) * ldt + k0 + 8 * c) = o; }
    LDS_WAIT(); asm volatile("" ::: "memory");
}
template <int MAP> __device__ __forceinline__ int map_row(int n0) {
    if (MAP == 1) { const int j = n0 < FF ? n0 : n0 - FF; return ((j >> 7) << 8) + (j & 127) + (n0 < FF ? 0 : 128); }
    if (MAP == 2) { return n0 < 4096 ? n0 : (n0 < 4160 ? 8192 + (n0 - 4096) : 4096 + (n0 - 4160)); }
    if (MAP == 3) { const int h = n0 >> 8, r = n0 & 255; return r < 128 ? h * 128 + r : 1024 + h * 128 + (r - 128); }
    return n0;
}
template <int MAP> __device__ __forceinline__ void transpose_matrix(const float* W, int K, int N, bf16_t* WT, LAS float* scr, int gw, int NGW, int lane) {
    const int nnb = N / 32, nit = (K / 64) * nnb;
    for (int it = gw; it < nit; it += NGW) { const int kb = it / nnb, nb = it - kb * nnb; transpose_item(W, N, kb * 64, nb * 32, WT, K, map_row<MAP>(nb * 32), scr, lane); }
}
__device__ __forceinline__ int tok_pos(int m) { return m < NPROMPT ? (m & (SEQ - 1)) : PAST + ((m - NPROMPT) & (DEC_T - 1)); }
__device__ __forceinline__ int tok_krow(int m) { return m < NPROMPT ? m : NPROMPT + ((m - NPROMPT) >> 4) * KEYS_S + PAST + ((m - NPROMPT) & 15); }

__device__ __forceinline__ void ln_row_finish(f32x4 (&v)[8], const float* gam, const float* bet, float* frow, bf16_t* brow, int lane) {
    float s = 0.f;
#pragma unroll
    for (int j = 0; j < 8; ++j) s += (v[j][0] + v[j][1]) + (v[j][2] + v[j][3]);
    const float mean = wave_sum(s) * (1.f / DM); float s2 = 0.f;
#pragma unroll
    for (int j = 0; j < 8; ++j) { v[j] = v[j] - mean; s2 += (v[j][0] * v[j][0] + v[j][1] * v[j][1]) + (v[j][2] * v[j][2] + v[j][3] * v[j][3]); }
    const float rstd = 1.f / sqrtf(wave_sum(s2) * (1.f / DM) + LN_EPS);
    f32x4* fo = (f32x4*)frow + lane; u32x2* bo = (u32x2*)brow + lane;
#pragma unroll
    for (int j = 0; j < 8; ++j) { const f32x4 g = ((const f32x4*)gam)[64 * j + lane], b = ((const f32x4*)bet)[64 * j + lane]; const f32x4 o = v[j] * rstd * g + b;
        if (frow) fo[64 * j] = o; if (brow) { u32x2 w; w.x = pk2(o[0], o[1]); w.y = pk2(o[2], o[3]); bo[64 * j] = w; } }
}
template <int NCH, bool RBF>
__device__ __forceinline__ void ln_phase(LAS unsigned char* lds, const bf16_t* Y, const float* gam, const float* bet, float* F0, float* F1, bf16_t* HBo, const bf16_t* slab, const void* R1, float alpha, float sc, int bx, int G, int tid, int wave, int lane) {
    const int gw = bx * NWAVES + wave, NGW = G * NWAVES;
    for (int sr = bx; sr < NSAMPLE; sr += G) {
        const u32x2* sp = (const u32x2*)(slab + (size_t)sr * DM) + tid;
        f32x4 a = {0.f, 0.f, 0.f, 0.f};
#pragma unroll
        for (int c = 0; c < NCH; ++c) { const u32x2 w = sp[(size_t)c * (NSAMPLE * DM / 4)]; a += (f32x4){pg8::bf_lo(w.x), pg8::bf_hi(w.x), pg8::bf_lo(w.y), pg8::bf_hi(w.y)}; }
        f32x4 rr;
        if (RBF) { const u32x2 w = ((const u32x2*)((const bf16_t*)R1 + (size_t)sr * DM))[tid]; rr = (f32x4){pg8::bf_lo(w.x), pg8::bf_hi(w.x), pg8::bf_lo(w.y), pg8::bf_hi(w.y)}; }
        else rr = ((const f32x4*)((const float*)R1 + (size_t)sr * DM))[tid];
        ((LAS f32x4*)lds)[tid] = rr * alpha + a * sc;
        __syncthreads();
        if (wave == 0) { f32x4 v[8];
#pragma unroll
            for (int j = 0; j < 8; ++j) v[j] = ((const LAS f32x4*)lds)[64 * j + lane];
            ln_row_finish(v, gam, bet, F1 ? F1 + (size_t)sr * DM : nullptr, HBo ? HBo + (size_t)(NPROMPT + sr) * DM : nullptr, lane); }
        __syncthreads();
    }
    for (int m = gw; m < NPROMPT; m += NGW) {
        const u32x2* yr = (const u32x2*)(Y + (size_t)m * DM) + lane; f32x4 v[8];
#pragma unroll
        for (int j = 0; j < 8; ++j) { const u32x2 w = yr[64 * j]; v[j] = (f32x4){pg8::bf_lo(w.x), pg8::bf_hi(w.x), pg8::bf_lo(w.y), pg8::bf_hi(w.y)}; }
        ln_row_finish(v, gam, bet, F0 ? F0 + (size_t)m * DM : nullptr, HBo ? HBo + (size_t)m * DM : nullptr, lane);
    }
}

#define MFMA32(a, b, c) __builtin_amdgcn_mfma_f32_32x32x16_bf16((a), (b), (c), 0, 0, 0)
__device__ __forceinline__ bf16x8 pack8f(const f32x4 a, const f32x4 b) { return __builtin_bit_cast(bf16x8, pk8(a, b)); }
__device__ __forceinline__ int pi32(int r) { return (r & ~12) | ((r & 4) << 1) | ((r & 8) >> 1); }
__device__ __forceinline__ void store_ot(bf16_t* op, const f32x16 (&o)[4], float sc, int hi) {
#pragma unroll
    for (int dt = 0; dt < 4; ++dt)
#pragma unroll
        for (int g = 0; g < 4; ++g) { u32x2 w; w.x = pk2(o[dt][4 * g] * sc, o[dt][4 * g + 1] * sc); w.y = pk2(o[dt][4 * g + 2] * sc, o[dt][4 * g + 3] * sc);
            *(u32x2*)(op + dt * 32 + 8 * g + 4 * hi) = w; }
}

__device__ __forceinline__ void sb_scores(const bf16x8 (&kf)[8], const bf16x8 (&qf)[8], bool diag, int key0, int qpos, int hi, float& R, bf16x8& pf0, bf16x8& pf1) {
    f32x16 st;
#pragma unroll
    for (int i = 0; i < 16; ++i) st[i] = 0.f;
#pragma unroll
    for (int ks = 0; ks < 8; ++ks) st = MFMA32(kf[ks], qf[ks], st);
    float l1[16], lb[16];
#pragma unroll
    for (int i = 0; i < 16; ++i) { const float zz = st[i]; const float e = __builtin_amdgcn_exp2f(-__builtin_fabsf(zz)); const float sp = fmaxf(zz, 0.f) + __builtin_amdgcn_logf(1.f + e);
        l1[i] = -sp; lb[i] = zz - sp;
        if (diag) { const int key = key0 + 16 * (i >> 3) + 8 * hi + (i & 7); const bool vis = key < qpos; l1[i] = vis ? l1[i] : 0.f; lb[i] = vis ? lb[i] : -INFINITY; } }
    float g0 = 0.f, g1 = 0.f;
#pragma unroll
    for (int i = 0; i < 8; ++i) { g0 += l1[i]; g1 += l1[8 + i]; }
    const float pg0 = __shfl_xor(g0, 32), pg1 = __shfl_xor(g1, 32);
    float p[16];
    { float run = R + (hi ? 0.f : pg1);
#pragma unroll
      for (int i = 15; i >= 8; --i) { p[i] = __builtin_amdgcn_exp2f(lb[i] + run); run += l1[i]; }
      run = R + g1 + pg1 + (hi ? 0.f : pg0);
#pragma unroll
      for (int i = 7; i >= 0; --i) { p[i] = __builtin_amdgcn_exp2f(lb[i] + run); run += l1[i]; } }
    R += (g0 + g1) + (pg0 + pg1);
    pf0 = pack8f((f32x4){p[0], p[1], p[2], p[3]}, (f32x4){p[4], p[5], p[6], p[7]}); pf1 = pack8f((f32x4){p[8], p[9], p[10], p[11]}, (f32x4){p[12], p[13], p[14], p[15]});
}
constexpr int SK_PITCH = 272, SV_PITCH = 136, SK_BYTES = 64 * SK_PITCH, SV_BYTES = 128 * SV_PITCH, ST_BYTES = SK_BYTES + SV_BYTES;
static_assert(2 * ST_BYTES + 64 <= RING_BYTES && 8 * 32 * 4 + 9 * 64 * 32 * 4 <= RING_BYTES, "SB LDS");
__device__ __forceinline__ void sb_prompt_unit(LAS unsigned char* lds, int b, int h, int j, const bf16_t* QS, const float* Kp, const float* Vp, bf16_t* OSB, int tid, int lane, int wave) {
    const int r = lane & 31, hi = lane >> 5;
    const int Q0 = j * 256, qpos = Q0 + 32 * wave + r, qrow = b * SEQ + qpos, NT = (Q0 + 256) / 64;
    const bf16_t* qp = QS + (size_t)qrow * 1024 + h * 128 + 8 * hi;
    bf16x8 qf[8];
#pragma unroll
    for (int ks = 0; ks < 8; ++ks) qf[ks] = *(const bf16x8*)(qp + 16 * ks);
    f32x16 o[4];
#pragma unroll
    for (int dt = 0; dt < 4; ++dt)
#pragma unroll
        for (int i = 0; i < 16; ++i) o[dt][i] = 0.f;
    float R = 0.f; int done = 0;
    volatile LAS int* flags = (volatile LAS int*)(lds + 2 * ST_BYTES);
    const float* gK = Kp + (size_t)(b * SEQ) * 1024 + h * 128;
    const float* gV = Vp + (size_t)(b * SEQ) * 1024 + h * 128;
    f32x4 ka[2][2]; float va[8][2];
#define SB_ISSUE(t) do { const int kb_ = Q0 + 256 - 64 * ((t) + 1); \
        _Pragma("unroll") for (int jj = 0; jj < 2; ++jj) { const int idx = tid + 512 * jj; const float* p_ = gK + (size_t)(kb_ + (idx >> 4)) * 1024 + (idx & 15) * 8; ka[jj][0] = *(const f32x4*)p_; ka[jj][1] = *(const f32x4*)(p_ + 4); } \
        _Pragma("unroll") for (int jj = 0; jj < 8; ++jj) { const int idx = tid + 512 * jj; const float* p_ = gV + (size_t)(kb_ + 2 * (idx >> 7)) * 1024 + (idx & 127); va[jj][0] = p_[0]; va[jj][1] = p_[1024]; } } while (0)
#define SB_COMMIT(buf) do { LAS unsigned char* B_ = lds + (buf) * ST_BYTES; \
        _Pragma("unroll") for (int jj = 0; jj < 2; ++jj) { const int idx = tid + 512 * jj; *(LAS u32x4*)(B_ + (idx >> 4) * SK_PITCH + (idx & 15) * 16) = pk8(ka[jj][0], ka[jj][1]); } \
        _Pragma("unroll") for (int jj = 0; jj < 8; ++jj) { const int idx = tid + 512 * jj; *(LAS unsigned*)(B_ + SK_BYTES + (idx & 127) * SV_PITCH + (idx >> 7) * 4) = pk2(va[jj][0], va[jj][1]); } } while (0)
    const int pr = pi32(r);
    SB_ISSUE(0); SB_COMMIT(0); __syncthreads();
    for (int t = 0; t < NT; ++t) {
        if (t + 1 < NT) SB_ISSUE(t + 1);
        const int kbase = Q0 + 256 - 64 * (t + 1);
        const LAS unsigned char* Bt = lds + (t & 1) * ST_BYTES;
#pragma unroll
        for (int sub = 1; sub >= 0; --sub) {
            const int key0 = kbase + 32 * sub;
            if (!done && key0 <= Q0 + 32 * wave) {
                bf16x8 kf[8];
                { const LAS unsigned char* kp = Bt + (32 * sub + pr) * SK_PITCH + hi * 16;
#pragma unroll
                  for (int ks = 0; ks < 8; ++ks) kf[ks] = *(const LAS bf16x8*)(kp + ks * 32); }
                bf16x8 pf0, pf1; sb_scores(kf, qf, key0 == Q0 + 32 * wave, key0, qpos, hi, R, pf0, pf1);
                const LAS unsigned char* vp = Bt + SK_BYTES + r * SV_PITCH + (32 * sub + 8 * hi) * 2;
#pragma unroll
                for (int dt = 0; dt < 4; ++dt) {
                    const u32x2 a0 = *(const LAS u32x2*)(vp + dt * 32 * SV_PITCH), a1 = *(const LAS u32x2*)(vp + dt * 32 * SV_PITCH + 8), c0 = *(const LAS u32x2*)(vp + dt * 32 * SV_PITCH + 32), c1 = *(const LAS u32x2*)(vp + dt * 32 * SV_PITCH + 40);
                    o[dt] = MFMA32(__builtin_bit_cast(bf16x8, (u32x4){a0.x, a0.y, a1.x, a1.y}), pf0, o[dt]); o[dt] = MFMA32(__builtin_bit_cast(bf16x8, (u32x4){c0.x, c0.y, c1.x, c1.y}), pf1, o[dt]); }
                if (__all(R < -160.f)) done = 1;
            }
        }
        if (lane == 0) flags[(t & 1) * 8 + wave] = done;
        if (t + 1 < NT) SB_COMMIT((t + 1) & 1);
        __syncthreads();
        int alld = 1;
#pragma unroll
        for (int w = 0; w < 8; ++w) alld &= flags[(t & 1) * 8 + w];
        if (alld) break;
    }
#undef SB_ISSUE
#undef SB_COMMIT
    store_ot(OSB + (size_t)qrow * 1024 + h * 128, o, 1.f, hi);
    __syncthreads();
}
__device__ __forceinline__ void sb_sample_unit(LAS unsigned char* lds, int b, int h, const bf16_t* QS, const float* cK, const float* cV, const float* nK, const float* nV, bf16_t* OSB, int lane, int wave) {
    const int r = lane & 31, hi = lane >> 5;
    const int qi = r < DEC_T ? r : DEC_T - 1, qpos = PAST + qi, qrow = NPROMPT + b * DEC_T + qi, cl = hi * 16 + (r & 15);
    const bool valid = r < DEC_T;
    const bf16_t* qp = QS + (size_t)qrow * 1024 + h * 128 + 8 * hi;
    bf16x8 qf[8];
#pragma unroll
    for (int ks = 0; ks < 8; ++ks) qf[ks] = *(const bf16x8*)(qp + 16 * ks);
    float Rcarry = 0.f;
    LAS float* RT = (LAS float*)lds;
    LAS float* OP = (LAS float*)(lds + 8 * 32 * 4);
    LAS float* OA = OP + 8 * 64 * 32;
    if (wave == 0 && valid) {
#pragma unroll
        for (int i = 0; i < 64; ++i) OA[i * 32 + cl] = 0.f; }
    const int pr = pi32(r);
    for (int base = PAST / 32; base >= 0; base -= NWAVES) {
        const int kt = base - wave;
        f32x16 o[4];
#pragma unroll
        for (int dt = 0; dt < 4; ++dt)
#pragma unroll
            for (int i = 0; i < 16; ++i) o[dt][i] = 0.f;
        float Rl = 0.f;
        if (kt >= 0) {
            const float* Kb; const float* Vb; int nvalid = 32;
            if (kt < PAST / 32) { const size_t off = ((size_t)b * PAST + kt * 32) * 1024 + h * 128; Kb = cK + off; Vb = cV + off; }
            else { const size_t off = (size_t)(b * DEC_T) * 1024 + h * 128; Kb = nK + off; Vb = nV + off; nvalid = DEC_T; }
            bf16x8 kf[8];
            { const float* kr = Kb + (size_t)(pr < nvalid ? pr : nvalid - 1) * 1024 + 8 * hi;
#pragma unroll
              for (int ks = 0; ks < 8; ++ks) kf[ks] = pack8f(*(const f32x4*)(kr + 16 * ks), *(const f32x4*)(kr + 16 * ks + 4)); }
            bf16x8 pf0, pf1; sb_scores(kf, qf, kt == PAST / 32, kt * 32, qpos, hi, Rl, pf0, pf1);
#pragma unroll
            for (int s2 = 0; s2 < 2; ++s2) { float vv[4][8];
#pragma unroll
                for (int jj = 0; jj < 8; ++jj) { const int kl = 16 * s2 + 8 * hi + jj; const float* vp = Vb + (size_t)(kl < nvalid ? kl : nvalid - 1) * 1024 + r;
#pragma unroll
                    for (int dt = 0; dt < 4; ++dt) vv[dt][jj] = vp[32 * dt]; }
#pragma unroll
                for (int dt = 0; dt < 4; ++dt) o[dt] = MFMA32(pack8f((f32x4){vv[dt][0], vv[dt][1], vv[dt][2], vv[dt][3]}, (f32x4){vv[dt][4], vv[dt][5], vv[dt][6], vv[dt][7]}), s2 ? pf1 : pf0, o[dt]); }
        }
        if (valid) RT[wave * 32 + cl] = Rl;
        __syncthreads();
        float Rpre = Rcarry, Rall = Rcarry;
#pragma unroll
        for (int w = 0; w < NWAVES; ++w) { const float x = RT[w * 32 + cl]; Rall += x; Rpre += (w < wave) ? x : 0.f; }
        const float sc = __builtin_amdgcn_exp2f(Rpre);
        if (valid) {
#pragma unroll
            for (int dt = 0; dt < 4; ++dt)
#pragma unroll
                for (int i = 0; i < 16; ++i) OP[(wave * 64 + dt * 16 + i) * 32 + cl] = o[dt][i] * sc; }
        __syncthreads();
        if (wave == 0 && valid) {
#pragma unroll 4
            for (int i = 0; i < 64; ++i) { float a = OA[i * 32 + cl];
#pragma unroll
                for (int w = 0; w < NWAVES; ++w) a += OP[(w * 64 + i) * 32 + cl];
                OA[i * 32 + cl] = a; } }
        Rcarry = Rall;
        __syncthreads();
        if (__all(Rcarry < -160.f)) break;
    }
    if (wave == 0 && valid) { f32x16 oacc[4];
#pragma unroll
        for (int dt = 0; dt < 4; ++dt)
#pragma unroll
            for (int i = 0; i < 16; ++i) oacc[dt][i] = OA[(dt * 16 + i) * 32 + cl];
        store_ot(OSB + (size_t)qrow * 1024 + h * 128, oacc, 1.f, hi); }
    __syncthreads();
}

__device__ __forceinline__ void mla_softmax_pv_prep(const f32x16& st, f32x16 (&o)[4], float& mrun, float& lsum, bf16x8& pf0, bf16x8& pf1) {
    float mx = st[0];
#pragma unroll
    for (int i = 1; i < 16; ++i) mx = fmaxf(mx, st[i]);
    mx = fmaxf(mx, __shfl_xor(mx, 32));
    if (!__all(mx - mrun <= 6.f)) { const float mnew = fmaxf(mrun, mx), alpha = __builtin_amdgcn_exp2f(mrun - mnew); lsum *= alpha; mrun = mnew;
#pragma unroll
        for (int dt = 0; dt < 4; ++dt)
#pragma unroll
            for (int i = 0; i < 16; ++i) o[dt][i] *= alpha; }
    float p[16], ps = 0.f;
#pragma unroll
    for (int i = 0; i < 16; ++i) { p[i] = __builtin_amdgcn_exp2f(st[i] - mrun); ps += p[i]; }
    lsum += ps;
    pf0 = pack8f((f32x4){p[0], p[1], p[2], p[3]}, (f32x4){p[4], p[5], p[6], p[7]}); pf1 = pack8f((f32x4){p[8], p[9], p[10], p[11]}, (f32x4){p[12], p[13], p[14], p[15]});
}
constexpr int MK_PITCH = 400, MV_PITCH = 144, MK_BYTES = 64 * MK_PITCH, MV_BYTES = 128 * MV_PITCH, MT_BYTES = MK_BYTES + MV_BYTES;
static_assert(2 * MT_BYTES <= RING_BYTES && 4 * 64 * 66 * 4 <= RING_BYTES, "MLA LDS");
__device__ __forceinline__ void mla_prompt_unit(LAS unsigned char* lds, int b, int h, int qi, const bf16_t* QM, const bf16_t* KN, const bf16_t* VT, const bf16_t* krP, bf16_t* OML, int tid, int lane, int wave) {
    const int r = lane & 31, hi = lane >> 5, qsub = wave & 3, kgrp = wave >> 2;
    const int qrow = b * SEQ + qi * 128 + qsub * 32 + r, NT = 2 * qi + 2, ntw = (qsub < 2) ? NT - 1 : NT, krow0 = b * SEQ;
    const bf16_t* qp = QM + (size_t)qrow * 1536 + h * 192 + 8 * hi;
    bf16x8 qf[12];
#pragma unroll
    for (int ks = 0; ks < 12; ++ks) qf[ks] = *(const bf16x8*)(qp + 16 * ks);
    f32x16 o[4];
#pragma unroll
    for (int dt = 0; dt < 4; ++dt)
#pragma unroll
        for (int i = 0; i < 16; ++i) o[dt][i] = 0.f;
    float mrun = -1e30f, lsum = 0.f;
    const int kr0 = tid >> 4, kc0 = tid & 15, rr = tid >> 3, rc = tid & 7;
    const bf16_t* gk = KN + (size_t)(krow0 + kr0) * 1024 + h * 128 + kc0 * 8;
    const bf16_t* gr = krP + (size_t)(krow0 + rr) * 64 + 8 * rc;
    const bf16_t* gv = VT + (size_t)(h * 128 + rr) * VPITCH + krow0 + rc * 8;
    const int lk = kr0 * MK_PITCH + kc0 * 16, lr = rr * MK_PITCH + 256 + rc * 16, lv = MK_BYTES + rr * MV_PITCH + rc * 16;
    u32x4 ak0, ak1, av0, av1, bk0, bk1, bv0, bv1, ar1, br1;
#define MLA_ISSUE(P, t) do { P##k0 = *(const u32x4*)(gk + (size_t)(t) * 65536); P##k1 = *(const u32x4*)(gk + (size_t)(t) * 65536 + 32768); P##r1 = *(const u32x4*)(gr + (size_t)(t) * 4096); \
        P##v0 = *(const u32x4*)(gv + (t) * 64); P##v1 = *(const u32x4*)(gv + (t) * 64 + (size_t)64 * VPITCH); } while (0)
#define MLA_COMMIT(P, buf) do { LAS unsigned char* B_ = lds + (buf) * MT_BYTES; *(LAS u32x4*)(B_ + lk) = P##k0; *(LAS u32x4*)(B_ + lk + 32 * MK_PITCH) = P##k1; \
        *(LAS u32x4*)(B_ + lr) = P##r1; *(LAS u32x4*)(B_ + lv) = P##v0; *(LAS u32x4*)(B_ + lv + 64 * MV_PITCH) = P##v1; } while (0)
#define MLA_COMPUTE(t, buf) do { if ((t) < ntw) { const LAS unsigned char* Bt = lds + (buf) * MT_BYTES; f32x16 st; \
            _Pragma("unroll") for (int i = 0; i < 16; ++i) st[i] = 0.f; \
            _Pragma("unroll") for (int ks = 0; ks < 12; ++ks) st = MFMA32(*(const LAS bf16x8*)(Bt + ko + ks * 32), qf[ks], st); \
            bf16x8 pf0, pf1; mla_softmax_pv_prep(st, o, mrun, lsum, pf0, pf1); \
            _Pragma("unroll") for (int dt = 0; dt < 4; ++dt) { o[dt] = MFMA32(*(const LAS bf16x8*)(Bt + vo + dt * 32 * MV_PITCH), pf0, o[dt]); o[dt] = MFMA32(*(const LAS bf16x8*)(Bt + vo + dt * 32 * MV_PITCH + 32), pf1, o[dt]); } } } while (0)
    const int pr = pi32(r);
    const int ko = (32 * kgrp + pr) * MK_PITCH + hi * 16, vo = MK_BYTES + r * MV_PITCH + (32 * kgrp + 8 * hi) * 2;
    MLA_ISSUE(a, 0); MLA_ISSUE(b, 1); MLA_COMMIT(a, 0); __syncthreads();
    for (int t = 0; t < NT; t += 2) {
        if (t + 2 < NT) MLA_ISSUE(a, t + 2);
        MLA_COMPUTE(t, 0);
        MLA_COMMIT(b, 1);
        __syncthreads();
        if (t + 3 < NT) MLA_ISSUE(b, t + 3);
        MLA_COMPUTE(t + 1, 1);
        if (t + 2 < NT) MLA_COMMIT(a, 0);
        __syncthreads();
    }
#undef MLA_ISSUE
#undef MLA_COMMIT
#undef MLA_COMPUTE
    LAS float* X = (LAS float*)lds;
    if (kgrp == 1) { X[(0 * 4 + qsub) * 64 + lane] = mrun; X[(1 * 4 + qsub) * 64 + lane] = lsum;
#pragma unroll
        for (int dt = 0; dt < 4; ++dt)
#pragma unroll
            for (int i = 0; i < 16; ++i) X[((2 + dt * 16 + i) * 4 + qsub) * 64 + lane] = o[dt][i]; }
    __syncthreads();
    if (kgrp == 0) { const float m2 = X[(0 * 4 + qsub) * 64 + lane], l2 = X[(1 * 4 + qsub) * 64 + lane]; const float mnew = fmaxf(mrun, m2), a1 = __builtin_amdgcn_exp2f(mrun - mnew), a2 = __builtin_amdgcn_exp2f(m2 - mnew);
        lsum = lsum * a1 + l2 * a2;
#pragma unroll
        for (int dt = 0; dt < 4; ++dt)
#pragma unroll
            for (int i = 0; i < 16; ++i) o[dt][i] = o[dt][i] * a1 + X[((2 + dt * 16 + i) * 4 + qsub) * 64 + lane] * a2;
        lsum += __shfl_xor(lsum, 32);
        store_ot(OML + (size_t)qrow * 1024 + h * 128, o, 1.f / lsum, hi); }
    __syncthreads();
}
__device__ __forceinline__ void mla_sample_unit(LAS unsigned char* lds, int b, int h, const bf16_t* QM, const bf16_t* KN, const bf16_t* VT, const float* krC, const float* krN, bf16_t* OML, int lane, int wave) {
    const int r = lane & 31, hi = lane >> 5;
    const int qi = r < DEC_T ? r : DEC_T - 1, qrow = NPROMPT + b * DEC_T + qi, krow0 = NPROMPT + b * KEYS_S;
    const bf16_t* qp = QM + (size_t)qrow * 1536 + h * 192 + 8 * hi;
    bf16x8 qf[12];
#pragma unroll
    for (int ks = 0; ks < 12; ++ks) qf[ks] = *(const bf16x8*)(qp + 16 * ks);
    f32x16 o[4];
#pragma unroll
    for (int dt = 0; dt < 4; ++dt)
#pragma unroll
        for (int i = 0; i < 16; ++i) o[dt][i] = 0.f;
    float mrun = -1e30f, lsum = 0.f;
    const int pr = pi32(r);
    const bf16_t* vbase = VT + (size_t)(h * 128 + r) * VPITCH + krow0 + 8 * hi;
    for (int kt = wave; kt < PAST / 32 + 1; kt += NWAVES) {
        f32x16 st;
#pragma unroll
        for (int i = 0; i < 16; ++i) st[i] = 0.f;
        { const bf16_t* kp = KN + (size_t)(krow0 + kt * 32 + pr) * 1024 + h * 128 + 8 * hi;
#pragma unroll
          for (int ks = 0; ks < 8; ++ks) st = MFMA32(*(const bf16x8*)(kp + 16 * ks), qf[ks], st);
          const float* rp = (kt < PAST / 32) ? krC + ((size_t)b * PAST + kt * 32 + pr) * 64 : krN + (size_t)(b * DEC_T + (pr < DEC_T ? pr : DEC_T - 1)) * 64;
#pragma unroll
          for (int ks = 0; ks < 4; ++ks) { const f32x4 x1 = *(const f32x4*)(rp + 8 * ks + 4 * hi), x2 = *(const f32x4*)(rp + 32 + 8 * ks + 4 * hi);
              st = MFMA32(pack8f((f32x4){x1[0], x2[0], x1[1], x2[1]}, (f32x4){x1[2], x2[2], x1[3], x2[3]}), qf[8 + ks], st); } }
        if (kt == PAST / 32) {
#pragma unroll
            for (int i = 8; i < 16; ++i) st[i] = -INFINITY;
        }
        __builtin_amdgcn_sched_barrier(0);
        bf16x8 pf0, pf1; mla_softmax_pv_prep(st, o, mrun, lsum, pf0, pf1);
        __builtin_amdgcn_sched_barrier(0);
        const bf16_t* vp = vbase + kt * 32;
#pragma unroll
        for (int dt = 0; dt < 4; ++dt) { o[dt] = MFMA32(*(const bf16x8*)(vp + (size_t)dt * 32 * VPITCH), pf0, o[dt]); o[dt] = MFMA32(*(const bf16x8*)(vp + (size_t)dt * 32 * VPITCH + 16), pf1, o[dt]); }
    }
    LAS float* X = (LAS float*)lds;
    const int cl = hi * 16 + r;
    if (wave > 0 && r < DEC_T) { X[(0 * 7 + wave - 1) * 32 + cl] = mrun; X[(1 * 7 + wave - 1) * 32 + cl] = lsum;
#pragma unroll
        for (int dt = 0; dt < 4; ++dt)
#pragma unroll
            for (int i = 0; i < 16; ++i) X[((2 + dt * 16 + i) * 7 + wave - 1) * 32 + cl] = o[dt][i]; }
    __syncthreads();
    if (wave == 0) {
        if (r < DEC_T) {
#pragma unroll 1
            for (int w = 0; w < 7; ++w) { const float m2 = X[(0 * 7 + w) * 32 + cl], l2 = X[(1 * 7 + w) * 32 + cl]; const float mnew = fmaxf(mrun, m2), a1 = __builtin_amdgcn_exp2f(mrun - mnew), a2 = __builtin_amdgcn_exp2f(m2 - mnew);
                lsum = lsum * a1 + l2 * a2; mrun = mnew;
#pragma unroll
                for (int dt = 0; dt < 4; ++dt)
#pragma unroll
                    for (int i = 0; i < 16; ++i) o[dt][i] = o[dt][i] * a1 + X[((2 + dt * 16 + i) * 7 + w) * 32 + cl] * a2; }
        }
        lsum += __shfl_xor(lsum, 32);
        if (r < DEC_T) store_ot(OML + (size_t)qrow * 1024 + h * 128, o, 1.f / lsum, hi);
    }
    __syncthreads();
}

#ifndef MK_N_LAUNCHES
#define MK_N_LAUNCHES 1
#endif
constexpr int NPHASE = 15;
constexpr int N_LAUNCHES = MK_N_LAUNCHES;
static_assert(N_LAUNCHES == 1 || N_LAUNCHES == NPHASE, "MK_N_LAUNCHES is 1 or 15");
__device__ unsigned g_bar[XCD_BAR_WORDS + 64];
constexpr int GB_DONE = XCD_BAR_WORDS;
struct Args { const float* in[25]; float* out; unsigned char* ws; int ph_lo, ph_hi; };
static_assert(sizeof(Args) == 27 * 8 + 8, "Args has no padding");

__global__ void __launch_bounds__(NWAVES * 64, 2) fwd_kernel(Args args) {
    extern __shared__ __attribute__((aligned(16))) unsigned char lds_raw[];
    LAS unsigned char* lds = (LAS unsigned char*)lds_raw;
    volatile LAS unsigned* MISC = (volatile LAS unsigned*)(lds + MISC_OFF);
    const int tid = threadIdx.x, lane = tid & 63, wave = __builtin_amdgcn_readfirstlane(tid >> 6);
    const int G = gridDim.x, bx = blockIdx.x;
    const int gw = bx * NWAVES + wave, NGW = G * NWAVES;
    unsigned char* ws = args.ws; float* out = args.out;
    for (int u = tid; u < (LDS_BYTES - LDSCTL_OFF) / 4; u += NWAVES * 64) ((LAS unsigned*)(lds + LDSCTL_OFF))[u] = 0u;
    __syncthreads();
    XcdBarrier bar; bar.bar = g_bar; bar.x = 0; bar.st = nullptr;
    if (N_LAUNCHES == 1) bar = xcd_barrier_post(g_bar, MISC + 8);
    const int lo = args.ph_lo, hi = args.ph_hi;
#define IN(k) (lo <= (k) && (k) < hi)
#define SEAM(k) do { if (N_LAUNCHES == 1 && IN(k) && IN((k) + 1)) xcd_barrier(bar); } while (0)

    const float* x_p = args.in[0]; const float* x_s = args.in[1]; const float* cache_k = args.in[2]; const float* cache_v = args.in[3]; const float* cache_ckv = args.in[4]; const float* cache_kr = args.in[5];
    float* TAB = (float*)(ws + WS_TAB);
    bf16_t* W1I = (bf16_t*)(ws + WS_W1I); bf16_t* W1O = (bf16_t*)(ws + WS_W1O); bf16_t* WIN = (bf16_t*)(ws + WS_WIN); bf16_t* WUQ = (bf16_t*)(ws + WS_WUQ); bf16_t* WKV = (bf16_t*)(ws + WS_WKV);
    bf16_t* WBS = (bf16_t*)(ws + WS_WBS); bf16_t* WBM = (bf16_t*)(ws + WS_WBM); bf16_t* WO = (bf16_t*)(ws + WS_WO); bf16_t* W2I = (bf16_t*)(ws + WS_W2I); bf16_t* W2O = (bf16_t*)(ws + WS_W2O);
    bf16_t* HB = (bf16_t*)(ws + WS_HB); bf16_t* ACT = (bf16_t*)(ws + WS_ACT); bf16_t* Y = (bf16_t*)(ws + WS_Y); float* H = (float*)(ws + WS_H);
    bf16_t* QS = (bf16_t*)(ws + WS_QS); float* CQ = (float*)(ws + WS_CQ); float* CKV = (float*)(ws + WS_CKV); float* KR = (float*)(ws + WS_KR); bf16_t* Gt = (bf16_t*)(ws + WS_G);
    bf16_t* CKA = (bf16_t*)(ws + WS_CKA); bf16_t* CQB = (bf16_t*)(ws + WS_CQB); bf16_t* QM = (bf16_t*)(ws + WS_QM); bf16_t* KN = (bf16_t*)(ws + WS_KN); bf16_t* VT = (bf16_t*)(ws + WS_VT);
    bf16_t* SLAB = (bf16_t*)(ws + WS_CQ);
    bf16_t* KRB = (bf16_t*)(ws + WS_KRB);
    bf16_t* OSB = (bf16_t*)(ws + WS_OSB); bf16_t* OML = (bf16_t*)(ws + WS_OML); float* T = (float*)(ws + WS_T); bf16_t* MG = (bf16_t*)(ws + WS_MG);

    if (IN(0)) {
        LAS float* scr = (LAS float*)(lds + wave * 16384);
        transpose_matrix<1>(args.in[6], DM, 2 * FF, W1I, scr, gw, NGW, lane);
        { u32x4* z = (u32x4*)(WIN + (size_t)8256 * DM); const u32x4 zero = {0u, 0u, 0u, 0u};
          for (int i = bx * (NWAVES * 64) + tid; i < (NIN - 8256) * DM / 8; i += G * NWAVES * 64) z[i] = zero; }
        for (int m = gw; m < MTOK; m += NGW) { const float* xr = (m < NPROMPT ? x_p + (size_t)m * DM : x_s + (size_t)(m - NPROMPT) * DM) + lane * 8; bf16_t* xo = HB + (size_t)m * DM + lane * 8;
#pragma unroll
            for (int j = 0; j < 4; ++j) *(u32x4*)(xo + j * 512) = pk8(*(const f32x4*)(xr + j * 512), *(const f32x4*)(xr + j * 512 + 4)); }
        for (int i = bx * (NWAVES * 64) + tid; i < SEQ * 32; i += G * NWAVES * 64) { const int pos = i >> 5, fi = i & 31; const float inv = powf(10000.f, -(float)(2 * fi) / 64.f); const float ang = (float)pos * inv;
            TAB[2 * i] = cosf(ang); TAB[2 * i + 1] = sinf(ang); }
    }
    SEAM(0);
    if (IN(1)) { pg8::Gemm g{HB, W1I, MTOK, 2 * FF, DM}; pg8::StaticOrder S; S.init(MTOK, 2 * FF, G, bx, g.K); pg8::EpiSwiGLU E{ACT, FF};
        pg8::gemm_phase<pg8::EpiSwiGLU, pg8::StaticOrder, true, true>(lds, g, S, E);
        constexpr int R1 = (MTOK / 256) * (2 * FF / 256) % 256;
        if (G == 256 ? bx >= R1 : true) { const int fw = (G == 256 ? (bx - R1) : bx) * NWAVES + wave, FNW = (G == 256 ? (256 - R1) : G) * NWAVES; LAS float* scr = (LAS float*)(lds + wave * 16384);
            transpose_matrix<0>(args.in[7], FF, DM, W1O, scr, fw, FNW, lane);
            transpose_matrix<2>(args.in[10], DM, 8256, WIN, scr, fw, FNW, lane);
            transpose_matrix<3>(args.in[15], 512, 2048, WKV, scr, fw, FNW, lane);
        { const float* Wuq = args.in[13];
          for (int rho = fw; rho < 1536; rho += FNW) { const int hh = rho / 192, j = rho - hh * 192; const int src = j < 128 ? rho : hh * 192 + 128 + (((j - 128) & 1) ? 32 + ((j - 128) >> 1) : ((j - 128) >> 1));
              const float* wp = Wuq + src + (size_t)(lane * 8) * 1536; f32x4 a, c;
#pragma unroll
              for (int e = 0; e < 4; ++e) { a[e] = wp[(size_t)e * 1536]; c[e] = wp[(size_t)(4 + e) * 1536]; }
              *(u32x4*)(WUQ + (size_t)rho * 512 + lane * 8) = pk8(a, c); } }
        } }
    SEAM(1);
    if (IN(2)) { pg8::Gemm g{ACT, W1O, MTOK, DM, FF}; pg8::SplitOrder S; S.init(DM, G, bx, g.K); pg8::EpiResid E{x_p, x_s, Y, ALPHA, 0.5f, SLAB};
        pg8::gemm_phase<pg8::EpiResid, pg8::SplitOrder, true, true>(lds, g, S, E); }
    SEAM(2);
    if (IN(3)) ln_phase<pg8::split_nch(FF), false>(lds, Y, args.in[8], args.in[9], nullptr, nullptr, HB, SLAB, x_s, ALPHA, 0.5f, bx, G, tid, wave, lane);
    SEAM(3);
    if (IN(4)) { pg8::Gemm g{HB, WIN, MTOK, NIN, DM}; pg8::StaticOrder S; S.init(MTOK, NIN, G, bx, g.K);
        pg8::EpiWin E{QS, out, CQ, KR, Gt, args.in[11], SBQ_SCALE};
        pg8::gemm_phase<pg8::EpiWin, pg8::StaticOrder, true, true>(lds, g, S, E);
        constexpr int R4 = (MTOK / 256) * (NIN / 256) % 256;
        if (G == 256 ? bx >= R4 : true) { const int fw = (G == 256 ? (bx - R4) : bx) * NWAVES + wave, FNW = (G == 256 ? (256 - R4) : G) * NWAVES; LAS float* scr = (LAS float*)(lds + wave * 16384);
            transpose_matrix<1>(args.in[21], DM, 2 * FF, W2I, scr, fw, FNW, lane);
            for (int rr = fw; rr < DEC_B * PAST; rr += FNW) { const int b = rr >> 10, key = rr & (PAST - 1); const float* p = cache_ckv + (size_t)rr * 512 + lane * 8;
                *(u32x4*)(CKA + (size_t)(NPROMPT + b * KEYS_S + key) * 512 + lane * 8) = pk8(*(const f32x4*)p, *(const f32x4*)(p + 4)); }
        } }
    SEAM(4);
    if (IN(5)) {
        const float* gcq = args.in[12]; const float* gckv = args.in[14];
        const f32x4 gq0 = *(const f32x4*)(gcq + lane * 8), gq1 = *(const f32x4*)(gcq + lane * 8 + 4), gk0 = *(const f32x4*)(gckv + lane * 8), gk1 = *(const f32x4*)(gckv + lane * 8 + 4);
        f32x4 nq0, nq1, nk0, nk1; float nx1 = 0.f, nx2 = 0.f, ncs = 0.f, nsn = 0.f;
#define P5_LOAD(m_) do { const float* p_ = CQ + (size_t)(m_) * 512 + lane * 8; nq0 = *(const f32x4*)p_; nq1 = *(const f32x4*)(p_ + 4); const float* q_ = CKV + (size_t)(m_) * 512 + lane * 8; nk0 = *(const f32x4*)q_; nk1 = *(const f32x4*)(q_ + 4); \
            if (lane < 32) { nx1 = KR[(size_t)(m_) * 64 + lane]; nx2 = KR[(size_t)(m_) * 64 + 32 + lane]; const int pos_ = tok_pos(m_); ncs = TAB[(size_t)pos_ * 64 + 2 * lane]; nsn = TAB[(size_t)pos_ * 64 + 2 * lane + 1]; } } while (0)
        if (gw < MTOK) P5_LOAD(gw);
        for (int m = gw; m < MTOK; m += NGW) {
            const f32x4 a = nq0, c = nq1, a2 = nk0, c2 = nk1; const float x1 = nx1, x2 = nx2, cs = ncs, sn = nsn;
            if (m + NGW < MTOK) P5_LOAD(m + NGW);
            { const float ss = wave_sum((a[0] * a[0] + a[1] * a[1]) + (a[2] * a[2] + a[3] * a[3]) + (c[0] * c[0] + c[1] * c[1]) + (c[2] * c[2] + c[3] * c[3]));
              const float rs = 1.f / sqrtf(ss * (1.f / 512.f) + RMS_EPS);
              *(u32x4*)(CQB + (size_t)m * 512 + lane * 8) = pk8(a * rs * gq0, c * rs * gq1); }
            { const float ss = wave_sum((a2[0] * a2[0] + a2[1] * a2[1]) + (a2[2] * a2[2] + a2[3] * a2[3]) + (c2[0] * c2[0] + c2[1] * c2[1]) + (c2[2] * c2[2] + c2[3] * c2[3]));
              const float rs = 1.f / sqrtf(ss * (1.f / 512.f) + RMS_EPS);
              const f32x4 y0 = a2 * rs * gk0, y1 = c2 * rs * gk1;
              float* po = (m < NPROMPT ? out + O_CKVP + (size_t)m * 512 : out + O_CKVS + (size_t)(m - NPROMPT) * 512) + lane * 8; *(f32x4*)po = y0; *(f32x4*)(po + 4) = y1;
              *(u32x4*)(CKA + (size_t)tok_krow(m) * 512 + lane * 8) = pk8(y0, y1); }
            if (lane < 32) { float* po = (m < NPROMPT ? out + O_KRP + (size_t)m * 64 : out + O_KRS + (size_t)(m - NPROMPT) * 64); const float o1 = x1 * cs - x2 * sn, o2 = x2 * cs + x1 * sn; po[lane] = o1; po[32 + lane] = o2; if (m < NPROMPT) ((unsigned*)KRB)[(size_t)m * 32 + lane] = pk2(o1, o2); }
        }
#undef P5_LOAD
        for (int i = bx * (NWAVES * 64) + tid; i < 1024 * 8; i += G * NWAVES * 64) { const u32x4 zero = {0u, 0u, 0u, 0u}; *(u32x4*)(VT + (size_t)(i >> 3) * VPITCH + KROWS + (i & 7) * 8) = zero; }
    }
    SEAM(5);
    if (IN(6)) {
        { pg8::Gemm g{CQB, WUQ, MTOK, 1536, 512}; pg8::StaticOrder S; S.init(MTOK, 1536, G, bx, g.K); pg8::EpiUq E{QM, TAB, MLAQ_SCALE};
          pg8::gemm_phase<pg8::EpiUq, pg8::StaticOrder, true, true>(lds, g, S, E); }
        { pg8::Gemm g{CKA, WKV, KROWS, 1024, 512}; pg8::StaticOrder S; S.init(KROWS, 1024, G, bx, g.K); pg8::EpiPlain E{KN, 1024};
          pg8::gemm_phase<pg8::EpiPlain, pg8::StaticOrder, true, true>(lds, g, S, E); }
        { pg8::Gemm g{WKV + (size_t)1024 * 512, CKA, 1024, KROWS, 512}; pg8::StaticOrder S; S.init(1024, KROWS, G, bx, g.K); pg8::EpiPlain E{VT, VPITCH};
          pg8::gemm_phase<pg8::EpiPlain, pg8::StaticOrder, true, true>(lds, g, S, E); }
        for (int u = bx; u < 2 * 8 * (SEQ / 256); u += G) sb_prompt_unit(lds, u >> 7, (u >> 4) & 7, u & 15, QS, out + O_KP, out + O_VP, OSB, tid, lane, wave);
        for (int u = (G == 256 ? bx - 128 : bx); u >= 0 && u < DEC_B * 8; u += G) sb_sample_unit(lds, u >> 3, u & 7, QS, cache_k, cache_v, out + O_KS, out + O_VS, OSB, lane, wave);
    }
    SEAM(6);
    if (IN(7)) {
        { const int bh = (bx >> 4) & 15, j = bx & 15;
          for (int c0 = bx; c0 < 256; c0 += G) { const int c = (G == 256) ? ((c0 & 7) * 32 + (c0 >> 3)) : c0;
              const int bh2 = c >> 4, j2 = c & 15;
              mla_prompt_unit(lds, bh2 >> 3, bh2 & 7, 31 - j2, QM, KN, VT, KRB, OML, tid, lane, wave);
              mla_prompt_unit(lds, bh2 >> 3, bh2 & 7, j2, QM, KN, VT, KRB, OML, tid, lane, wave); }
          (void)bh; (void)j; }
        for (int u = bx; u < DEC_B * 8; u += G) mla_sample_unit(lds, u >> 3, u & 7, QM, KN, VT, cache_kr, out + O_KRS, OML, lane, wave);
        if (G == 256 ? bx >= 128 : true) {
            const int fw = (G == 256 ? (bx - 128) : bx) * NWAVES + wave, FNW = (G == 256 ? 128 : G) * NWAVES; LAS float* scr = (LAS float*)(lds + wave * 16384);
            transpose_matrix<0>(args.in[16], 1024, DM, WBS, scr, fw, FNW, lane);
            transpose_matrix<0>(args.in[17], 1024, DM, WBM, scr, fw, FNW, lane);
            transpose_matrix<0>(args.in[18], DM, DM, WO, scr, fw, FNW, lane); }
    }
    SEAM(7);
    if (IN(8)) {
        bf16_t* SL8 = (bf16_t*)(ws + WS_KN);
        { pg8::Gemm g{OSB, WBS, MTOK, DM, 1024, (long)WS_OML - (long)WS_OSB, (long)WS_WBM - (long)WS_WBS}; pg8::SplitOrder2 S; S.init(DM, G, bx, g.K); pg8::EpiChainBr E{Gt, MG, SL8};
          pg8::gemm_phase<pg8::EpiChainBr, pg8::SplitOrder2, true, true>(lds, g, S, E); }
    }
    SEAM(8);
    if (IN(9)) {
        const u32x2* SL8 = (const u32x2*)(ws + WS_KN);
        for (int sr = bx; sr < NSAMPLE; sr += G) {
            const u32x2* sp = SL8 + (size_t)sr * (DM / 4) + tid; f32x4 a = {0.f, 0.f, 0.f, 0.f}, c = a;
#pragma unroll
            for (int k = 0; k < 8; ++k) { const u32x2 wa = sp[(size_t)k * (NSAMPLE * DM / 4)], wc = sp[(size_t)(8 + k) * (NSAMPLE * DM / 4)];
                a += (f32x4){pg8::bf_lo(wa.x), pg8::bf_hi(wa.x), pg8::bf_lo(wa.y), pg8::bf_hi(wa.y)}; c += (f32x4){pg8::bf_lo(wc.x), pg8::bf_hi(wc.x), pg8::bf_lo(wc.y), pg8::bf_hi(wc.y)}; }
            const bf16_t* gp = Gt + (size_t)(NPROMPT + sr) * 4096 + tid * 4; const u32x2 gs = *(const u32x2*)gp, gm = *(const u32x2*)(gp + 2048);
            const f32x4 g0 = {pg8::bf_lo(gs.x), pg8::bf_hi(gs.x), pg8::bf_lo(gs.y), pg8::bf_hi(gs.y)}, g1 = {pg8::bf_lo(gm.x), pg8::bf_hi(gm.x), pg8::bf_lo(gm.y), pg8::bf_hi(gm.y)};
            const f32x4 o = g0 * a + g1 * c; u32x2 w; w.x = pk2(o[0], o[1]); w.y = pk2(o[2], o[3]);
            *(u32x2*)(MG + (size_t)(NPROMPT + sr) * DM + tid * 4) = w; }
    }
    SEAM(9);
    if (IN(10)) { pg8::Gemm g{MG, WO, MTOK, DM, DM}; pg8::SplitOrder S; S.init(DM, G, bx, g.K); pg8::EpiResidB E{HB, Y, ALPHA, 1.f, SLAB};
        pg8::gemm_phase<pg8::EpiResidB, pg8::SplitOrder, true, true>(lds, g, S, E); }
    SEAM(10);
    if (IN(11)) ln_phase<pg8::split_nch(DM), true>(lds, Y, args.in[19], args.in[20], nullptr, nullptr, HB, SLAB, HB + (size_t)NPROMPT * DM, ALPHA, 1.f, bx, G, tid, wave, lane);
    SEAM(11);
    if (IN(12)) { pg8::Gemm g{HB, W2I, MTOK, 2 * FF, DM}; pg8::StaticOrder S; S.init(MTOK, 2 * FF, G, bx, g.K); pg8::EpiSwiGLU E{ACT, FF};
        pg8::gemm_phase<pg8::EpiSwiGLU, pg8::StaticOrder, true, true>(lds, g, S, E);
        constexpr int R12 = (MTOK / 256) * (2 * FF / 256) % 256;
        if (G == 256 ? bx >= R12 : true) { const int fw = (G == 256 ? (bx - R12) : bx) * NWAVES + wave, FNW = (G == 256 ? (256 - R12) : G) * NWAVES; LAS float* scr = (LAS float*)(lds + wave * 16384);
            transpose_matrix<0>(args.in[22], FF, DM, W2O, scr, fw, FNW, lane); } }
    SEAM(12);
    if (IN(13)) { pg8::Gemm g{ACT, W2O, MTOK, DM, FF}; pg8::SplitOrder S; S.init(DM, G, bx, g.K); pg8::EpiResidB E{HB, Y, ALPHA, 0.5f, SLAB};
        pg8::gemm_phase<pg8::EpiResidB, pg8::SplitOrder, true, true>(lds, g, S, E); }
    SEAM(13);
    if (IN(14)) ln_phase<pg8::split_nch(FF), true>(lds, Y, args.in[23], args.in[24], out + O_YP, out + O_YS, nullptr, SLAB, HB + (size_t)NPROMPT * DM, ALPHA, 0.5f, bx, G, tid, wave, lane);
#undef IN
#undef SEAM
    if (N_LAUNCHES == 1) {
        __syncthreads();
        if (tid == 0) MISC[12] = (xb_add(&g_bar[GB_DONE], 1u) == (unsigned)G - 1u) ? 1u : 0u;
        __syncthreads();
        if (MISC[12]) { for (int i = tid; i < XCD_BAR_WORDS + 64; i += NWAVES * 64) __hip_atomic_store(&g_bar[i], 0u, __ATOMIC_RELAXED, __HIP_MEMORY_SCOPE_AGENT); }
    }
}

extern "C" void kernel_launch(void* const* d_in, const int* in_sizes, int n_in, void* d_out, int out_size, void* d_ws, size_t ws_size, hipStream_t stream) {
    static int grid = 0;
    if (grid == 0) {
        if (n_in != 25 || out_size != (int)O_END || ws_size < WS_END) { fprintf(stderr, "kernel_launch: expected 25 inputs, %zu outputs, >= %zu B workspace; got %d, %d, %zu\n", (size_t)O_END, (size_t)WS_END, n_in, out_size, ws_size); grid = -1; return; }
        int dev = 0, cus = 0, per_cu = 0;
        if (hipGetDevice(&dev) != hipSuccess || hipDeviceGetAttribute(&cus, hipDeviceAttributeMultiprocessorCount, dev) != hipSuccess) { grid = -1; return; }
        if (hipFuncSetAttribute((const void*)fwd_kernel, hipFuncAttributeMaxDynamicSharedMemorySize, LDS_BYTES) != hipSuccess) { fprintf(stderr, "kernel_launch: hipFuncSetAttribute failed\n"); grid = -1; return; }
        if (hipOccupancyMaxActiveBlocksPerMultiprocessor(&per_cu, (const void*)fwd_kernel, NWAVES * 64, LDS_BYTES) != hipSuccess || per_cu < 1) fprintf(stderr, "kernel_launch: occupancy query says %d\n", per_cu);
        (void)hipGetLastError();
        grid = cus;
        if (grid != 256) { fprintf(stderr, "kernel_launch: built for a 256-CU device (the split-K order deals exactly 256 prompt tiles), found %d CUs; nothing launched\n", cus); grid = -1; return; }
    }
    if (grid < 0) return;
    Args a{};
    for (int i = 0; i < 25; ++i) a.in[i] = (const float*)d_in[i];
    a.out = (float*)d_out; a.ws = (unsigned char*)d_ws;
    for (int li = 0; li < N_LAUNCHES; ++li) {
        a.ph_lo = (N_LAUNCHES == 1) ? 0 : li; a.ph_hi = (N_LAUNCHES == 1) ? NPHASE : li + 1;
        hipLaunchKernelGGL(fwd_kernel, dim3(grid), dim3(NWAVES * 64), LDS_BYTES, stream, a);
        const hipError_t le = hipPeekAtLastError();
        if (le != hipSuccess) { fprintf(stderr, "kernel_launch: launch %d failed: %s\n", li, hipGetErrorName(le)); break; }
    }
}
```
